# Optimizing an MI355X kernel written in HIP

```python
import jax, jax.numpy as jnp
from jax import lax
import numpy as np

D_MODEL = 1024
BATCH = 4
SEQ = 4096
DEPTH = 4

GRID_W = 64
CTX_LEN = 256
D_MIX = D_MODEL
D_A = D_MIX // 2
A_GROUPS = 4
A_GROUP_DIM = D_A // A_GROUPS
CHUNK = 128
D_B = D_MIX - D_A
POOL_WINDOWS = (2, 4, 8, 16)
B_GROUPS = len(POOL_WINDOWS)
B_GROUP_DIM = D_B // B_GROUPS
N_HEADS_NA = 16
HEAD_DIM = D_MODEL // N_HEADS_NA
NA_ROWS = 8
NA_COLS = 16
D_FF = ((8 * D_MODEL + 3 * 256 - 1) // (3 * 256)) * 256
N_EVEN = (DEPTH + 1) // 2
N_ODD = DEPTH // 2
EPS = 1e-6
NEG_INF = -1e30
MOD_INIT = 0.5

kernel_name = "hybrid_dit_gmlp_pool_natten"


def rms_norm(x, g):
    xf = x.astype(jnp.float32)
    y = xf * lax.rsqrt(jnp.mean(xf * xf, axis=-1, keepdims=True) + EPS)
    return (y * g.astype(jnp.float32)).astype(x.dtype)


def layer_norm(x, g):
    xf = x.astype(jnp.float32)
    xc = xf - jnp.mean(xf, axis=-1, keepdims=True)
    y = xc * lax.rsqrt(jnp.mean(xc * xc, axis=-1, keepdims=True) + EPS)
    return (y * g.astype(jnp.float32)).astype(x.dtype)


def adaln(cond, w_mod, b_mod):
    m = jax.nn.silu(cond) @ w_mod + b_mod
    return jnp.split(m[..., None, :], 6, axis=-1)


def modulate(h, shift, scale):
    return h * (1 + scale) + shift


def chunk_gating(u, v, w_s, b_s):
    b, l, _ = v.shape
    vg = v.reshape(b, l // CHUNK, CHUNK, A_GROUPS, A_GROUP_DIM)
    mixed = jnp.einsum('gij,bnjgc->bnigc', w_s, vg) + b_s.T[:, :, None]
    return u * mixed.reshape(b, l, D_A)


def multiscale_pool(p, w_pool, pool_scale):
    b, l, _ = p.shape
    pf = p.astype(jnp.float32)
    cs = jnp.concatenate([jnp.zeros((b, 1, D_B), jnp.float32), jnp.cumsum(pf, axis=1)], axis=1)
    t = jnp.arange(l)
    pooled = []
    for g, w in enumerate(POOL_WINDOWS):
        lo = jnp.clip(t - w // 2, 0, l)
        hi = jnp.clip(t + w // 2, 0, l)
        cs_g = cs[..., g * B_GROUP_DIM:(g + 1) * B_GROUP_DIM]
        seg = jnp.take(cs_g, hi, axis=1) - jnp.take(cs_g, lo, axis=1)
        pooled.append(seg / (hi - lo).astype(jnp.float32)[None, :, None])
    pooled = jnp.stack(pooled, axis=2)
    diff = (pooled - pf.reshape(b, l, B_GROUPS, B_GROUP_DIM)).astype(p.dtype)
    y = jnp.einsum('blgc,gcd->blgd', diff, w_pool).reshape(b, l, D_B)
    return y * pool_scale


def ab_mixer(h, w_in, ln_v, w_s, b_s, w_pool, pool_scale, w_out):
    z = h @ w_in
    za = jax.nn.gelu(z[..., :2 * D_A])
    u, v = za[..., :D_A], layer_norm(za[..., D_A:], ln_v)
    ya = chunk_gating(u, v, w_s, b_s)
    yb = multiscale_pool(z[..., 2 * D_A:], w_pool, pool_scale)
    return jnp.concatenate([ya, yb], axis=-1) @ w_out


def na_mixer(h, hc, w_qkv, rpb, w_out, ctx_out):
    b, l, _ = h.shape
    rows = l // GRID_W
    kr = min(NA_ROWS, rows)
    scale = HEAD_DIM ** -0.5
    q, k, v = jnp.split(h @ w_qkv, 3, axis=-1)
    q = q.reshape(b, rows, GRID_W, N_HEADS_NA, HEAD_DIM)
    k = k.reshape(b, rows, GRID_W, N_HEADS_NA, HEAD_DIM)
    v = v.reshape(b, rows, GRID_W, N_HEADS_NA, HEAD_DIM)
    cl = hc.shape[1]
    qc, kc, vc = jnp.split(hc @ w_qkv, 3, axis=-1)
    kc = kc.reshape(b, cl, N_HEADS_NA, HEAD_DIM)
    vc = vc.reshape(b, cl, N_HEADS_NA, HEAD_DIM)
    r = jnp.arange(rows)
    row_start = jnp.clip(r - kr // 2, 0, rows - kr)
    row_idx = row_start[:, None] + jnp.arange(kr)
    k_rows = k[:, row_idx]
    v_rows = v[:, row_idx]
    s_nb = jnp.einsum('brqhd,brkwhd->bhrqkw', q, k_rows, preferred_element_type=jnp.float32) * scale
    col = jnp.arange(GRID_W)
    col_start = jnp.clip(col - NA_COLS // 2, 0, GRID_W - NA_COLS)
    col_mask = (col[None, :] >= col_start[:, None]) & (col[None, :] < col_start[:, None] + NA_COLS)
    dr = row_idx - r[:, None] + (NA_ROWS - 1)
    dc = jnp.clip(col[None, :] - col[:, None], -(NA_COLS - 1), NA_COLS - 1) + (NA_COLS - 1)
    bias = rpb[:, dr[:, None, :, None], dc[None, :, None, :]].astype(jnp.float32)
    s_nb = jnp.where(col_mask[None, None, None, :, None, :], s_nb + bias[None], NEG_INF)
    n_nb = kr * GRID_W
    s_nb = s_nb.reshape(b, N_HEADS_NA, rows, GRID_W, n_nb)
    s_cx = jnp.einsum('brqhd,bkhd->bhrqk', q, kc, preferred_element_type=jnp.float32) * scale
    p = jax.nn.softmax(jnp.concatenate([s_nb, s_cx], axis=-1), axis=-1)
    p_nb = p[..., :n_nb].reshape(b, N_HEADS_NA, rows, GRID_W, kr, GRID_W).astype(v.dtype)
    p_cx = p[..., n_nb:].astype(v.dtype)
    o = (jnp.einsum('bhrqkw,brkwhd->brqhd', p_nb, v_rows)
         + jnp.einsum('bhrqk,bkhd->brqhd', p_cx, vc))
    y = o.reshape(b, l, D_MODEL) @ w_out
    if ctx_out:
        qc = qc.reshape(b, cl, N_HEADS_NA, HEAD_DIM)
        sc = jnp.einsum('bqhd,bkhd->bhqk', qc, kc, preferred_element_type=jnp.float32) * scale
        pc = jax.nn.softmax(sc, axis=-1).astype(vc.dtype)
        oc = jnp.einsum('bhqk,bkhd->bqhd', pc, vc)
        yc = oc.reshape(b, cl, D_MODEL) @ w_out
    else:
        yc = None
    return y, yc


def swiglu(h, w_in, w_out):
    a, g = jnp.split(h @ w_in, 2, axis=-1)
    return (jax.nn.silu(a) * g) @ w_out


def setup_inputs(seed: int = 0) -> dict:
    key = jax.random.key(seed)
    ks = jax.random.split(key, 24)
    nrm = jax.random.normal
    f32 = jnp.float32
    return {
        "x": nrm(ks[0], (BATCH, SEQ, D_MODEL), f32),
        "c": nrm(ks[1], (BATCH, D_MODEL), f32),
        "ctx": nrm(ks[2], (BATCH, CTX_LEN, D_MODEL), f32),
        "c_ctx": nrm(ks[3], (D_MODEL,), f32),
        "w_mod": nrm(ks[4], (DEPTH, D_MODEL, 6 * D_MODEL), f32) * (MOD_INIT * D_MODEL ** -0.5),
        "b_mod": nrm(ks[5], (DEPTH, 6 * D_MODEL), f32) * 0.02,
        "norm_mix": 1.0 + 0.05 * nrm(ks[6], (DEPTH, D_MODEL), f32),
        "norm_ffn": 1.0 + 0.05 * nrm(ks[7], (DEPTH, D_MODEL), f32),
        "w_in_ab": nrm(ks[8], (N_EVEN, D_MODEL, 2 * D_A + D_B), f32) * D_MODEL ** -0.5,
        "ln_v": 1.0 + 0.05 * nrm(ks[9], (N_EVEN, D_A), f32),
        "w_spatial": nrm(ks[10], (N_EVEN, A_GROUPS, CHUNK, CHUNK), f32) * CHUNK ** -0.5,
        "b_spatial": 1.0 + 0.05 * nrm(ks[11], (N_EVEN, A_GROUPS, CHUNK), f32),
        "w_pool": nrm(ks[12], (N_EVEN, B_GROUPS, B_GROUP_DIM, B_GROUP_DIM), f32) * B_GROUP_DIM ** -0.5,
        "pool_scale": 1.0 + 0.05 * nrm(ks[13], (N_EVEN, D_B), f32),
        "w_out_ab": nrm(ks[14], (N_EVEN, D_MIX, D_MODEL), f32) * D_MIX ** -0.5,
        "w_qkv": nrm(ks[15], (N_ODD, D_MODEL, 3 * D_MODEL), f32) * D_MODEL ** -0.5,
        "rpb": nrm(ks[16], (N_ODD, N_HEADS_NA, 2 * NA_ROWS - 1, 2 * NA_COLS - 1), f32) * 0.1,
        "w_out_na": nrm(ks[17], (N_ODD, D_MODEL, D_MODEL), f32) * D_MODEL ** -0.5,
        "w_ffn_in": nrm(ks[18], (DEPTH, D_MODEL, 2 * D_FF), f32) * D_MODEL ** -0.5,
        "w_ffn_out": nrm(ks[19], (DEPTH, D_FF, D_MODEL), f32) * D_FF ** -0.5,
        "norm_final": 1.0 + 0.05 * nrm(ks[20], (D_MODEL,), f32),
    }


def reference(x, c, ctx, c_ctx, w_mod, b_mod, norm_mix, norm_ffn, w_in_ab, ln_v, w_spatial,
              b_spatial, w_pool, pool_scale, w_out_ab, w_qkv, rpb, w_out_na, w_ffn_in,
              w_ffn_out, norm_final):
    xc = ctx
    for i in range(DEPTH):
        last = i == DEPTH - 1
        odd = i % 2 == 1
        j = i // 2
        sh1, sc1, g1, sh2, sc2, g2 = adaln(c, w_mod[i], b_mod[i])
        h = modulate(rms_norm(x, norm_mix[i]), sh1, sc1)
        need_ctx = (not last) or odd
        if need_ctx:
            csh1, csc1, cg1, csh2, csc2, cg2 = adaln(c_ctx, w_mod[i], b_mod[i])
            hc = modulate(rms_norm(xc, norm_mix[i]), csh1, csc1)
        if odd:
            y, yc = na_mixer(h, hc, w_qkv[j], rpb[j], w_out_na[j], not last)
            x = x + g1 * y
            if not last:
                xc = xc + cg1 * yc
        else:
            ab = (w_in_ab[j], ln_v[j], w_spatial[j], b_spatial[j], w_pool[j], pool_scale[j], w_out_ab[j])
            x = x + g1 * ab_mixer(h, *ab)
            if not last:
                xc = xc + cg1 * ab_mixer(hc, *ab)
        x = x + g2 * swiglu(modulate(rms_norm(x, norm_ffn[i]), sh2, sc2), w_ffn_in[i], w_ffn_out[i])
        if not last:
            xc = xc + cg2 * swiglu(modulate(rms_norm(xc, norm_ffn[i]), csh2, csc2), w_ffn_in[i], w_ffn_out[i])
    return rms_norm(x, norm_final)
```

```cpp
#include <hip/hip_runtime.h>
#include <hip/hip_cooperative_groups.h>
#include <cstdio>
#include <cstdint>
namespace cg = cooperative_groups;
namespace pg8 {
#define PG8_LAS __attribute__((address_space(3)))
typedef unsigned short bf16_t;
typedef short bf16x8 __attribute__((ext_vector_type(8)));
typedef float f32x4 __attribute__((ext_vector_type(4)));
typedef unsigned u32x4 __attribute__((ext_vector_type(4)));
constexpr int BM = 256, BK = 64, HALF = 128, HTB = HALF * BK * 2  , STAGE_BYTES = 8 * HTB, NXCD = 8, WGM = 8;

__host__ __device__ __forceinline__ int lds_byte(int r, int c) { const int st = (r >> 4) * 2 + (c >> 5), rr = r & 15, cc = c & 31, ob = rr * 64 + cc * 2; return st * 1024 + (ob ^ (((ob >> 9) & 1) << 5)); }
__host__ __device__ __forceinline__ void stage_rc(int b, int& R, int& C) { const int st = b / 1024, sb = b % 1024, swz = sb ^ (((sb >> 9) & 1) << 5); R = (st >> 1) * 16 + swz / 64; C = (st & 1) * 32 + (swz % 64) / 2; }
__host__ __device__ __forceinline__ int perm32(int rho) { const int n = rho >> 4, i = rho & 15; return 8 * (i >> 2) + 4 * n + (i & 3); }

struct Unit { int pm, pn; };
struct Gemm { const bf16_t* A; const bf16_t* Bt; int M, N, K; };

struct StaticOrder {
    int nM, nN, nwg, G, c;
    __host__ __device__ void init(int M, int N, int G_, int c_) { nM = M / BM; nN = N / BM; nwg = nM * nN; G = G_; c = c_; }
    __host__ __device__ bool next(int i, Unit& u) const {
        const long L = (long)i * G + c; if (L >= nwg) return false;
        int wgid = (int)L; { const int q = nwg / NXCD, r = nwg % NXCD, xcd = wgid % NXCD, off = wgid / NXCD; wgid = (xcd < r ? xcd * (q + 1) : r * (q + 1) + (xcd - r) * q) + off; }
        const int nig = WGM * nN, gid = wgid / nig, fm = gid * WGM, gsz = (nM - fm) < WGM ? (nM - fm) : WGM;
        u.pm = fm + ((wgid % nig) % gsz); u.pn = (wgid % nig) / gsz; return true;
    }
    __device__ __forceinline__ void a_ready(const Unit&) const {}
    __device__ __forceinline__ void done(const Unit&) const {}
};

__device__ __forceinline__ unsigned cvt_pk_bf16(float lo, float hi) { unsigned r; asm volatile("v_cvt_pk_bf16_f32 %0, %1, %2" : "=v"(r) : "v"(lo), "v"(hi)); return r; }
typedef float f32x2 __attribute__((ext_vector_type(2)));
__device__ __forceinline__ float gelu_tanh_f(float x) {
    const float y = x * (0.7978845608f + 0.0356774081f * x * x);
    const float e = __builtin_amdgcn_exp2f(-2.885390082f * y);
    return x * __builtin_amdgcn_rcpf(1.0f + e);
}
template <int O> __device__ __forceinline__ float xshfl(float v) { static_assert(O < 32, "xshfl<O>: O < 32"); return __uint_as_float((unsigned)__builtin_amdgcn_ds_swizzle((int)__float_as_uint(v), (O << 10) | 0x1f)); }
__device__ __forceinline__ float xshfl32(float v, int lane) { return __uint_as_float((unsigned)__builtin_amdgcn_ds_bpermute((lane ^ 32) << 2, (int)__float_as_uint(v))); }
__device__ __forceinline__ float silu_f(float x) { return x * __builtin_amdgcn_rcpf(1.0f + __builtin_amdgcn_exp2f(-1.4426950409f * x)); }

struct EpiStoreBf16 {
    static constexpr bool PERM = true, AFTER_DRAIN = false;
    bf16_t* O; int ldc; int gelu_pn_lt; int scale_pn_lt; float scale0;
    __device__ __forceinline__ void operator()(const f32x4 (&acc)[2][2][4][2], const Unit& u, int wr, int wc, int fr, int fq) const {
        const int row0 = u.pm * BM + wr * 64 + fr; const int col0 = u.pn * BM + wc * 32 + 8 * fq;
        const bool act = u.pn < gelu_pn_lt; const float sc = (u.pn < scale_pn_lt) ? scale0 : 1.f;
#pragma unroll
        for (int ai = 0; ai < 2; ++ai)
#pragma unroll
            for (int m = 0; m < 4; ++m) { bf16_t* rowp = O + (size_t)(row0 + ai * HALF + m * 16) * ldc + col0;
#pragma unroll
                for (int bj = 0; bj < 2; ++bj) { f32x4 v0 = acc[ai][bj][m][0], v1 = acc[ai][bj][m][1];
                    if (act) {
#pragma unroll
                        for (int e = 0; e < 4; ++e) { v0[e] = gelu_tanh_f(v0[e]); v1[e] = gelu_tanh_f(v1[e]); } }
                    v0 = v0 * sc; v1 = v1 * sc; u32x4 w; w.x = cvt_pk_bf16(v0[0], v0[1]); w.y = cvt_pk_bf16(v0[2], v0[3]); w.z = cvt_pk_bf16(v1[0], v1[1]); w.w = cvt_pk_bf16(v1[2], v1[3]);
                    *(u32x4*)(rowp + bj * HALF) = w; } }
    }
};

struct EpiGVt {
    static constexpr bool PERM = true, AFTER_DRAIN = false;
    bf16_t* O; int ldc; float* stats;
    __device__ __forceinline__ void operator()(const f32x4 (&acc)[2][2][4][2], const Unit& u, int wr, int wc, int fr, int fq) const {
        const int row0 = u.pm * BM + wr * 64 + fr; const int col0 = u.pn * BM + wc * 32 + 8 * fq;
        const int slot = u.pm * 2 + wr;
#pragma unroll
        for (int bj = 0; bj < 2; ++bj) {
            float s[2][4], q[2][4];
#pragma unroll
            for (int n = 0; n < 2; ++n)
#pragma unroll
                for (int e = 0; e < 4; ++e) { s[n][e] = 0.f; q[n][e] = 0.f; }
#pragma unroll
            for (int ai = 0; ai < 2; ++ai)
#pragma unroll
                for (int m = 0; m < 4; ++m) { bf16_t* rowp = O + (size_t)(row0 + ai * HALF + m * 16) * ldc + col0;
                    f32x4 v0 = acc[ai][bj][m][0], v1 = acc[ai][bj][m][1];
#pragma unroll
                    for (int e = 0; e < 4; ++e) { v0[e] = gelu_tanh_f(v0[e]); v1[e] = gelu_tanh_f(v1[e]);
                        s[0][e] += v0[e]; q[0][e] += v0[e] * v0[e]; s[1][e] += v1[e]; q[1][e] += v1[e] * v1[e]; }
                    u32x4 w; w.x = cvt_pk_bf16(v0[0], v0[1]); w.y = cvt_pk_bf16(v0[2], v0[3]); w.z = cvt_pk_bf16(v1[0], v1[1]); w.w = cvt_pk_bf16(v1[2], v1[3]);
                    *(u32x4*)(rowp + bj * HALF) = w; }
#pragma unroll
            for (int n = 0; n < 2; ++n)
#pragma unroll
                for (int e = 0; e < 4; ++e) { float a = s[n][e], b = q[n][e];
                    a += xshfl<1>(a); b += xshfl<1>(b); a += xshfl<2>(a); b += xshfl<2>(b); a += xshfl<4>(a); b += xshfl<4>(b); a += xshfl<8>(a); b += xshfl<8>(b);
                    if (fr == 0) { float* p = stats + ((size_t)(col0 + bj * HALF + 4 * n + e) * 4 + slot) * 2; p[0] = a; p[1] = b; } }
            asm volatile("" ::: "memory");
        }
    }
};

struct EpiResGate {
    static constexpr bool PERM = false, AFTER_DRAIN = false;
    float* X; const float* gate_base;
    __device__ __forceinline__ void operator()(const f32x4 (&acc)[2][2][4][2], const Unit& u, int wr, int wc, int fr, int fq) const {
        const int cond = u.pm < 64 ? (u.pm >> 4) : 4; const float* gate = gate_base + cond * 6144;
        const int col0 = u.pn * BM + wc * 32 + 4 * fq;
        f32x4 gv[2][2];
#pragma unroll
        for (int bj = 0; bj < 2; ++bj)
#pragma unroll
            for (int n = 0; n < 2; ++n) gv[bj][n] = *(const f32x4*)(gate + col0 + bj * HALF + n * 16);
#pragma unroll
        for (int ai = 0; ai < 2; ++ai)
#pragma unroll
            for (int m = 0; m < 4; ++m) { float* rowp = X + (size_t)(u.pm * BM + ai * HALF + wr * 64 + m * 16 + fr) * 1024 + col0;
#pragma unroll
                for (int bj = 0; bj < 2; ++bj)
#pragma unroll
                    for (int n = 0; n < 2; ++n) { f32x4* p = (f32x4*)(rowp + bj * HALF + n * 16); *p = *p + gv[bj][n] * acc[ai][bj][m][n]; } }
    }
};

struct EpiSwiGLU {
    static constexpr bool PERM = true, AFTER_DRAIN = false;
    bf16_t* O; int ldc;
    __device__ __forceinline__ void operator()(const f32x4 (&acc)[2][2][4][2], const Unit& u, int wr, int wc, int fr, int fq) const {
        const int row0 = u.pm * BM + wr * 64 + fr; const int col0 = u.pn * HALF + wc * 32 + 8 * fq;
#pragma unroll
        for (int ai = 0; ai < 2; ++ai)
#pragma unroll
            for (int m = 0; m < 4; ++m) { bf16_t* rowp = O + (size_t)(row0 + ai * HALF + m * 16) * ldc + col0;
                f32x4 v0, v1;
#pragma unroll
                for (int e = 0; e < 4; ++e) { v0[e] = silu_f(acc[ai][0][m][0][e]) * acc[ai][1][m][0][e]; v1[e] = silu_f(acc[ai][0][m][1][e]) * acc[ai][1][m][1][e]; }
                u32x4 w; w.x = cvt_pk_bf16(v0[0], v0[1]); w.y = cvt_pk_bf16(v0[2], v0[3]); w.z = cvt_pk_bf16(v1[0], v1[1]); w.w = cvt_pk_bf16(v1[2], v1[3]);
                *(u32x4*)rowp = w; }
    }
};

template <class Epi, class Sched, bool ALIGN_EPI = false, bool SP2 = false>
__device__ __forceinline__ void gemm_phase(PG8_LAS unsigned char* lds, const Gemm g, const Sched& S, const Epi& E) {
    int tid_l = threadIdx.x; asm volatile("" : "+v"(tid_l));
    const int tid = tid_l, wid = __builtin_amdgcn_readfirstlane(tid >> 6), lane = tid & 63, wr = wid >> 2, wc = wid & 3, fr = lane & 15, fq = lane >> 4;
    const int K = g.K, nt = K / BK;
    unsigned voffA[2], voffB[2];
#pragma unroll
    for (int i = 0; i < 2; ++i) { int R, C; stage_rc(tid * 16 + i * 8192, R, C); const int Rb = Epi::PERM ? ((R & ~31) + perm32(R & 31)) : R;
        voffA[i] = (unsigned)(R * K + C) * 2u; voffB[i] = (unsigned)(Rb * K + C) * 2u; }
    const size_t kstep = (size_t)(BK * 2);
    const size_t hstep = (size_t)HALF * K * 2;
    const size_t tstep = 2 * hstep;
    const unsigned ldsw = (unsigned)wid * 1024u;
    const int aoff = lds_byte(wr * 64 + fr, fq * 8), boff = lds_byte(wc * 32 + fr, fq * 8);
#define PG8_SA(b, h) (((b) * 2 + (h)) * HTB)
#define PG8_SB(b, h) ((4 + (b) * 2 + (h)) * HTB)
#define PG8_STAGE(bufoff, gbase, voff) do { _Pragma("unroll") for (int _i = 0; _i < 2; ++_i) \
        __builtin_amdgcn_global_load_lds((const unsigned*)((const char*)(gbase) + (voff)[_i]), (PG8_LAS unsigned*)(lds + (bufoff) + ldsw + _i * 8192), 16, 0, 0); } while (0)
#define PG8_LDA(dst, b, h) do { _Pragma("unroll") for (int m = 0; m < 4; ++m) _Pragma("unroll") for (int k = 0; k < 2; ++k) dst[m][k] = *(const PG8_LAS bf16x8*)(lds + PG8_SA(b, h) + aoff + m * 2048 + k * 1024); } while (0)
#define PG8_LDB(dst, b, h) do { _Pragma("unroll") for (int n = 0; n < 2; ++n) _Pragma("unroll") for (int k = 0; k < 2; ++k) dst[n][k] = *(const PG8_LAS bf16x8*)(lds + PG8_SB(b, h) + boff + n * 2048 + k * 1024); } while (0)
#define PG8_MMA(ai, bj, At, Bt) do { __builtin_amdgcn_s_setprio(1); _Pragma("unroll") for (int m = 0; m < 4; ++m) _Pragma("unroll") for (int n = 0; n < 2; ++n) _Pragma("unroll") for (int k = 0; k < 2; ++k) \
        acc[ai][bj][m][n] = __builtin_amdgcn_mfma_f32_16x16x32_bf16(Bt[n][k], At[m][k], acc[ai][bj][m][n], 0, 0, 0); __builtin_amdgcn_s_setprio(0); } while (0)
#define PG8_WAIT_V(n) asm volatile("s_waitcnt vmcnt(" #n ")" ::: "memory")
#define PG8_WAIT_L(n) asm volatile("s_waitcnt lgkmcnt(" #n ")" ::: "memory")
#define PG8_BAR __builtin_amdgcn_s_barrier()
#define PG8_SCHED __builtin_amdgcn_sched_barrier(0)
    Unit cur, nxt; int ui = 0;
    if (!S.next(0, cur)) return;
    f32x4 acc[2][2][4][2];
#pragma unroll
    for (int a = 0; a < 2; ++a)
#pragma unroll
        for (int b = 0; b < 2; ++b)
#pragma unroll
            for (int m = 0; m < 4; ++m)
#pragma unroll
                for (int n = 0; n < 2; ++n) acc[a][b][m][n] = (f32x4){0.f, 0.f, 0.f, 0.f};
    bf16x8 At[4][2], B0[2][2], B1[2][2];
    const char* cA = (const char*)g.A + (size_t)cur.pm * tstep; const char* cB = (const char*)g.Bt + (size_t)cur.pn * tstep;
    S.a_ready(cur);
    if constexpr (SP2) {
        PG8_STAGE(PG8_SB(0, 0), cB, voffB); PG8_STAGE(PG8_SB(0, 1), cB + hstep, voffB); PG8_STAGE(PG8_SA(0, 0), cA, voffA); PG8_STAGE(PG8_SA(0, 1), cA + hstep, voffA);
        if (wr == 1) PG8_BAR;
        PG8_WAIT_V(2); PG8_BAR;
        PG8_STAGE(PG8_SB(1, 0), cB + kstep, voffB); PG8_STAGE(PG8_SA(1, 0), cA + kstep, voffA); PG8_STAGE(PG8_SB(1, 1), cB + hstep + kstep, voffB);
        PG8_WAIT_V(6); PG8_BAR;
    } else {
        PG8_STAGE(PG8_SB(0, 0), cB, voffB); PG8_STAGE(PG8_SA(0, 0), cA, voffA); PG8_STAGE(PG8_SB(0, 1), cB + hstep, voffB); PG8_STAGE(PG8_SA(0, 1), cA + hstep, voffA);
        if (wr == 1) PG8_BAR;
        PG8_WAIT_V(4); PG8_BAR;
        PG8_STAGE(PG8_SB(1, 0), cB + kstep, voffB); PG8_STAGE(PG8_SA(1, 0), cA + kstep, voffA); PG8_STAGE(PG8_SB(1, 1), cB + hstep + kstep, voffB);
        PG8_WAIT_V(6); PG8_BAR;
    }
    for (;;) {
        const bool has_next = S.next(ui + 1, nxt);
        const char* nA = has_next ? (const char*)g.A + (size_t)nxt.pm * tstep : cA; const char* nB = has_next ? (const char*)g.Bt + (size_t)nxt.pn * tstep : cB;
        for (int t = 0; t < nt; t += 2) {
            const bool last = (t == nt - 2);
            const char* a1 = cA + (size_t)(t + 1) * kstep;
            const char* a2 = last ? nA : cA + (size_t)(t + 2) * kstep; const char* b2 = last ? nB : cB + (size_t)(t + 2) * kstep;
            const char* a3 = a2 + kstep; const char* b3 = b2 + kstep;
            if (last && has_next) S.a_ready(nxt);
            if constexpr (SP2) {
            PG8_LDB(B0, 0, 0); PG8_LDB(B1, 0, 1); PG8_SCHED; PG8_LDA(At, 0, 0); PG8_STAGE(PG8_SA(1, 1), a1 + hstep, voffA);
            PG8_WAIT_V(8); PG8_WAIT_L(0); PG8_BAR; PG8_MMA(0, 0, At, B0); PG8_MMA(0, 1, At, B1); PG8_BAR; PG8_SCHED;
            PG8_LDA(At, 0, 1); PG8_STAGE(PG8_SB(0, 0), b2, voffB); PG8_STAGE(PG8_SB(0, 1), b2 + hstep, voffB); PG8_STAGE(PG8_SA(0, 0), a2, voffA);
            PG8_WAIT_V(8); PG8_WAIT_L(0); PG8_BAR; PG8_MMA(1, 0, At, B0); PG8_MMA(1, 1, At, B1); PG8_BAR; PG8_SCHED;
            PG8_LDB(B0, 1, 0); PG8_LDB(B1, 1, 1); PG8_SCHED; PG8_LDA(At, 1, 0); PG8_STAGE(PG8_SA(0, 1), a2 + hstep, voffA);
            PG8_WAIT_V(8); PG8_WAIT_L(0); PG8_BAR; PG8_MMA(0, 0, At, B0); PG8_MMA(0, 1, At, B1); PG8_BAR; PG8_SCHED;
            PG8_LDA(At, 1, 1); PG8_STAGE(PG8_SB(1, 0), b3, voffB); PG8_STAGE(PG8_SB(1, 1), b3 + hstep, voffB); PG8_STAGE(PG8_SA(1, 0), a3, voffA);
            PG8_WAIT_V(8); PG8_WAIT_L(0); PG8_BAR; PG8_MMA(1, 0, At, B0); PG8_MMA(1, 1, At, B1); PG8_BAR; PG8_SCHED;
            } else {
            PG8_LDB(B0, 0, 0); PG8_SCHED; PG8_LDA(At, 0, 0); PG8_STAGE(PG8_SA(1, 1), a1 + hstep, voffA);
            PG8_WAIT_L(8); PG8_BAR; PG8_WAIT_L(0); PG8_MMA(0, 0, At, B0); PG8_BAR; PG8_SCHED;
            PG8_LDB(B1, 0, 1); PG8_STAGE(PG8_SB(0, 0), b2, voffB);
            PG8_BAR; PG8_WAIT_L(0); PG8_MMA(0, 1, At, B1); PG8_BAR;
            PG8_LDA(At, 0, 1); PG8_STAGE(PG8_SA(0, 0), a2, voffA);
            PG8_BAR; PG8_WAIT_L(0); PG8_MMA(1, 0, At, B0); PG8_BAR; PG8_SCHED;
            PG8_STAGE(PG8_SB(0, 1), b2 + hstep, voffB);
            PG8_WAIT_V(6); PG8_BAR; PG8_MMA(1, 1, At, B1); PG8_BAR;
            PG8_LDB(B0, 1, 0); PG8_SCHED; PG8_LDA(At, 1, 0); PG8_STAGE(PG8_SA(0, 1), a2 + hstep, voffA);
            PG8_WAIT_L(8); PG8_BAR; PG8_WAIT_L(0); PG8_MMA(0, 0, At, B0); PG8_BAR; PG8_SCHED;
            PG8_LDB(B1, 1, 1); PG8_STAGE(PG8_SB(1, 0), b3, voffB);
            PG8_BAR; PG8_WAIT_L(0); PG8_MMA(0, 1, At, B1); PG8_BAR;
            PG8_LDA(At, 1, 1); PG8_STAGE(PG8_SA(1, 0), a3, voffA);
            PG8_BAR; PG8_WAIT_L(0); PG8_MMA(1, 0, At, B0); PG8_BAR; PG8_SCHED;
            PG8_STAGE(PG8_SB(1, 1), b3 + hstep, voffB);
            PG8_WAIT_V(6); PG8_BAR; PG8_MMA(1, 1, At, B1); PG8_BAR;
            }
        }
        if constexpr (ALIGN_EPI) { if (wr == 0) PG8_BAR; }
        if constexpr (!Epi::AFTER_DRAIN) { E(acc, cur, wr, wc, fr, fq); S.done(cur); }
        if (!has_next) break;
#pragma unroll
        for (int a = 0; a < 2; ++a)
#pragma unroll
            for (int b = 0; b < 2; ++b)
#pragma unroll
                for (int m = 0; m < 4; ++m)
#pragma unroll
                    for (int n = 0; n < 2; ++n) acc[a][b][m][n] = (f32x4){0.f, 0.f, 0.f, 0.f};
        cur = nxt; cA = nA; cB = nB; ++ui;
        if constexpr (ALIGN_EPI) { if (wr == 1) PG8_BAR; }
    }
    PG8_WAIT_V(0);
    if constexpr (!ALIGN_EPI) { if (wr == 0) PG8_BAR; }
    PG8_BAR;
    if constexpr (Epi::AFTER_DRAIN) { E.fused(acc, cur, wr, wc, fr, fq, lds, wid, lane); S.done(cur); }
#undef PG8_SA
#undef PG8_SB
#undef PG8_STAGE
#undef PG8_LDA
#undef PG8_LDB
#undef PG8_MMA
#undef PG8_WAIT_V
#undef PG8_WAIT_L
#undef PG8_BAR
#undef PG8_SCHED
}
}
#define LAS __attribute__((address_space(3)))
typedef unsigned short bf16;
typedef unsigned v4u __attribute__((ext_vector_type(4)));
typedef unsigned v2u __attribute__((ext_vector_type(2)));
typedef float f32x4 __attribute__((ext_vector_type(4)));
typedef short bf16x8 __attribute__((ext_vector_type(8)));

constexpr int NWAVES = 8, NT = 512;
constexpr int D = 1024, ML = 16384, MC = 1024, MA = ML + MC, SEQ = 4096, CTXL = 256, DFF = 2816, NFI = 2 * DFF;
constexpr float EPS = 1e-6f, LOG2E = 1.4426950408889634f;
constexpr size_t MiB = 1u << 20;
constexpr size_t WS_MOD = 1 * MiB;
constexpr size_t WS_STATS = 2 * MiB;
constexpr size_t WS_WS = 3 * MiB;
constexpr size_t WS_PRM = 3 * MiB + 512 * 1024;
constexpr int PRM_NMIX = 0, PRM_NFFN = 4096, PRM_LNV = 8192, PRM_BS = 9216, PRM_RPB = 10240, PRM_NFIN = 10240 + 14880, PRM_TOTAL = PRM_NFIN + 1024;
constexpr size_t WS_XW = 4 * MiB;
constexpr size_t WS_HN = 72 * MiB;
constexpr size_t WS_SCR = 106 * MiB;
constexpr size_t WS_H2 = WS_SCR;
constexpr size_t WS_QK = WS_SCR, WS_VT = WS_SCR + 68 * MiB, WS_O = WS_SCR + 102 * MiB;
constexpr size_t WS_UQ = WS_SCR, WS_GVT = WS_SCR + 34 * MiB, WS_Y = WS_SCR + 51 * MiB;
constexpr size_t WS_WIN = 242 * MiB;
constexpr size_t WS_WOAB = 248 * MiB;
constexpr size_t WS_WQKV = 252 * MiB;
constexpr size_t WS_WONA = 264 * MiB;
constexpr size_t WS_WFI = 268 * MiB;
constexpr size_t WS_WFO = 312 * MiB;
constexpr size_t WS_END = 334 * MiB;
constexpr int LDS_BYTES = 147456;

struct Args { const float* in[21]; float* out; unsigned char* ws; };

__device__ __forceinline__ float bf2f(unsigned b) { return __uint_as_float(b << 16); }
__device__ __forceinline__ unsigned pk2(float lo, float hi) { return pg8::cvt_pk_bf16(lo, hi); }
__device__ __forceinline__ float wave_sum(float v, int lane) {
    v += pg8::xshfl<1>(v); v += pg8::xshfl<2>(v); v += pg8::xshfl<4>(v); v += pg8::xshfl<8>(v); v += pg8::xshfl<16>(v); v += pg8::xshfl32(v, lane);
    return v;
}
#define LDS_WAIT() asm volatile("s_waitcnt lgkmcnt(0)" ::: "memory")

__device__ __forceinline__ void transpose_item(const float* W, int ldw, bf16* WT, int K, int k0, int n0, int drow0, LAS float* scr, int lane) {
#pragma unroll 8
    for (int i = 0; i < 32; ++i) { const int kk = 2 * i + (lane >> 5); scr[kk * 33 + (lane & 31)] = W[(size_t)(k0 + kk) * ldw + n0 + (lane & 31)]; }
    LDS_WAIT();
    const int c = lane & 7;
#pragma unroll
    for (int j = 0; j < 4; ++j) { const int n = (lane >> 3) + 8 * j; const LAS float* s = scr + (8 * c) * 33 + n;
        v4u o; o.x = pk2(s[0 * 33], s[1 * 33]); o.y = pk2(s[2 * 33], s[3 * 33]); o.z = pk2(s[4 * 33], s[5 * 33]); o.w = pk2(s[6 * 33], s[7 * 33]);
        *(v4u*)(WT + (size_t)(drow0 + n) * K + k0 + 8 * c) = o; }
    LDS_WAIT();
}

__device__ __forceinline__ void prologue(const Args& a, LAS unsigned char* lds, int tid, int lane, int wave, int bid, int G, int gw, int NGW) {
    unsigned char* ws = a.ws;
    {
        LAS float* scr = (LAS float*)(lds + wave * 16384);
        constexpr int I_IN = 16 * 32, I_SQ = 16 * 32, I_QKV = 16 * 96, I_FI = 16 * 176, I_FO = 44 * 32;
        constexpr int NITEMS = 2 * I_IN + 2 * I_SQ + 2 * I_QKV + 2 * I_SQ + 4 * I_FI + 4 * I_FO;
        for (int it = gw; it < NITEMS; it += NGW) {
            int r = it;
            if (r < 2 * I_IN) { const int j = r / I_IN; r -= j * I_IN; const int kb = r / 32, nb = r % 32, n0 = nb * 32;
                transpose_item(a.in[8] + (size_t)j * 1024 * 1536, 1536, (bf16*)(ws + WS_WIN) + (size_t)j * 1536 * 1024, 1024, kb * 64, n0, n0 < 512 ? n0 : n0 + 512, scr, lane); continue; } r -= 2 * I_IN;
            if (r < 2 * I_SQ) { const int j = r / I_SQ; r -= j * I_SQ; const int kb = r / 32, nb = r % 32;
                transpose_item(a.in[14] + (size_t)j * 1024 * 1024, 1024, (bf16*)(ws + WS_WOAB) + (size_t)j * 1024 * 1024, 1024, kb * 64, nb * 32, nb * 32, scr, lane); continue; } r -= 2 * I_SQ;
            if (r < 2 * I_QKV) { const int j = r / I_QKV; r -= j * I_QKV; const int kb = r / 96, nb = r % 96;
                transpose_item(a.in[15] + (size_t)j * 1024 * 3072, 3072, (bf16*)(ws + WS_WQKV) + (size_t)j * 3072 * 1024, 1024, kb * 64, nb * 32, nb * 32, scr, lane); continue; } r -= 2 * I_QKV;
            if (r < 2 * I_SQ) { const int j = r / I_SQ; r -= j * I_SQ; const int kb = r / 32, nb = r % 32;
                transpose_item(a.in[17] + (size_t)j * 1024 * 1024, 1024, (bf16*)(ws + WS_WONA) + (size_t)j * 1024 * 1024, 1024, kb * 64, nb * 32, nb * 32, scr, lane); continue; } r -= 2 * I_SQ;
            if (r < 4 * I_FI) { const int i = r / I_FI; r -= i * I_FI; const int kb = r / 176, nb = r % 176, n0 = nb * 32;
                const int jj = n0 < DFF ? n0 : n0 - DFF; const int drow0 = (jj >> 7) * 256 + (n0 < DFF ? 0 : 128) + (jj & 127);
                transpose_item(a.in[18] + (size_t)i * 1024 * NFI, NFI, (bf16*)(ws + WS_WFI) + (size_t)i * NFI * 1024, 1024, kb * 64, n0, drow0, scr, lane); continue; } r -= 4 * I_FI;
            { const int i = r / I_FO; r -= i * I_FO; const int kb = r / 32, nb = r % 32;
                transpose_item(a.in[19] + (size_t)i * DFF * 1024, 1024, (bf16*)(ws + WS_WFO) + (size_t)i * 1024 * DFF, DFF, kb * 64, nb * 32, nb * 32, scr, lane); }
        }
    }
    for (int e = bid * NT + tid; e < 2 * 4 * 128 * 128 / 2; e += G * NT) { const float2 v = *(const float2*)(a.in[10] + 2 * (size_t)e); ((unsigned*)(ws + WS_WS))[e] = pk2(v.x, v.y); }
    {
        float* prm = (float*)(ws + WS_PRM);
        for (int e = bid * NT + tid; e < PRM_TOTAL; e += G * NT) {
            float v;
            if (e < PRM_NFFN) v = a.in[6][e]; else if (e < PRM_LNV) v = a.in[7][e - PRM_NFFN]; else if (e < PRM_BS) v = a.in[9][e - PRM_LNV];
            else if (e < PRM_RPB) v = a.in[11][e - PRM_BS]; else if (e < PRM_NFIN) v = a.in[16][e - PRM_RPB] * LOG2E; else v = a.in[20][e - PRM_NFIN];
            prm[e] = v; }
        f32x4* xw = (f32x4*)(ws + WS_XW);
        for (int e = bid * NT + tid; e < MA * 256; e += G * NT) xw[e] = e < ML * 256 ? ((const f32x4*)a.in[0])[e] : ((const f32x4*)a.in[2])[e - ML * 256];
    }
    __syncthreads();
    for (int it = bid; it < 128; it += G) {
        const int j = it >> 6, g = (it >> 4) & 3, kb = it & 15, k0 = kb * 64;
        LAS float* wp = (LAS float*)lds; LAS float* wi = (LAS float*)(lds + 65536);
        const float* wpool = a.in[12] + (size_t)(j * 4 + g) * 16384;
#pragma unroll 4
        for (int i = 0; i < 32; ++i) wp[tid + 512 * i] = wpool[tid + 512 * i];
        const float* win = a.in[8] + (size_t)j * 1024 * 1536 + 1024 + g * 128;
#pragma unroll 4
        for (int i = 0; i < 16; ++i) { const int kk = (tid >> 7) + 4 * i, c = tid & 127; wi[kk * 129 + c] = win[(size_t)(k0 + kk) * 1536 + c]; }
        __syncthreads();
        const int kk = tid & 63, d0 = (tid >> 6) * 16;
        float acc[16];
#pragma unroll
        for (int i = 0; i < 16; ++i) acc[i] = 0.f;
        for (int c = 0; c < 128; ++c) { const float av = wi[kk * 129 + c];
#pragma unroll
            for (int i = 0; i < 16; ++i) acc[i] += av * wp[c * 128 + d0 + i]; }
        const float* ps = a.in[13] + j * 512 + g * 128 + d0;
        bf16* out = (bf16*)(ws + WS_WIN) + (size_t)j * 1536 * 1024 + (size_t)(512 + g * 128 + d0) * 1024 + k0 + kk;
#pragma unroll
        for (int i = 0; i < 16; ++i) out[(size_t)i * 1024] = (bf16)(pk2(acc[i] * ps[i], 0.f) & 0xffffu);
        __syncthreads();
    }
    {
        LAS float* sv = (LAS float*)lds;
        LAS float* red = (LAS float*)(lds + 20480);
        for (int e = tid; e < 5 * 1024; e += NT) { const float v = e < 4096 ? a.in[1][e] : a.in[3][e - 4096]; sv[e] = pg8::silu_f(v); }
        __syncthreads();
        for (int it = bid; it < 4 * 192; it += G) {
            const int layer = it / 192, n0 = (it % 192) * 32, col = tid & 31, ks = tid >> 5;
            const float* wm = a.in[4] + ((size_t)layer * 1024 + ks * 64) * 6144 + n0 + col;
            float acc[5] = {0.f, 0.f, 0.f, 0.f, 0.f};
#pragma unroll 8
            for (int k = 0; k < 64; ++k) { const float w = wm[(size_t)k * 6144];
#pragma unroll
                for (int c = 0; c < 5; ++c) acc[c] += sv[c * 1024 + ks * 64 + k] * w; }
#pragma unroll
            for (int c = 0; c < 5; ++c) red[(ks * 5 + c) * 32 + col] = acc[c];
            __syncthreads();
            if (tid < 160) { const int c = tid >> 5; float s = a.in[5][layer * 6144 + n0 + col];
#pragma unroll
                for (int q = 0; q < 16; ++q) s += red[(q * 5 + c) * 32 + col];
                ((float*)(ws + WS_MOD))[(size_t)(layer * 5 + c) * 6144 + n0 + col] = s; }
            __syncthreads();
        }
    }
}

__device__ __forceinline__ void rowpass(unsigned char* ws, int layer, int which, int Mrows, int lane, int gw, int NGW) {
    float* XW = (float*)(ws + WS_XW); bf16* HN = (bf16*)(ws + WS_HN);
    const float* gn = (const float*)(ws + WS_PRM) + (which ? PRM_NFFN : PRM_NMIX) + layer * 1024;
    const float* mod = (const float*)(ws + WS_MOD) + (size_t)layer * 5 * 6144 + (which ? 3 : 0) * 1024;
    f32x4 g4[4];
#pragma unroll
    for (int j = 0; j < 4; ++j) g4[j] = *(const f32x4*)(gn + 4 * lane + 256 * j);
    for (int m = gw; m < Mrows; m += NGW) {
        const float* src = XW + (size_t)m * D;
        const int cond = m < ML ? (m >> 12) : 4;
        const float* sh = mod + cond * 6144; const float* sc = sh + 1024;
        f32x4 v[4]; float s = 0.f;
#pragma unroll
        for (int j = 0; j < 4; ++j) { v[j] = *(const f32x4*)(src + 4 * lane + 256 * j); s += (v[j].x * v[j].x + v[j].y * v[j].y) + (v[j].z * v[j].z + v[j].w * v[j].w); }
        const float rstd = 1.0f / sqrtf(wave_sum(s, lane) * (1.f / D) + EPS);
#pragma unroll
        for (int j = 0; j < 4; ++j) {
            const f32x4 s4 = *(const f32x4*)(sc + 4 * lane + 256 * j), h4 = *(const f32x4*)(sh + 4 * lane + 256 * j);
            const f32x4 o = (v[j] * rstd) * g4[j] * (s4 + 1.0f) + h4;
            v2u w; w.x = pk2(o.x, o.y); w.y = pk2(o.z, o.w);
            *(v2u*)(HN + (size_t)m * D + 4 * lane + 256 * j) = w; }
    }
}

__device__ __forceinline__ void final_norm(unsigned char* ws, float* out, int lane, int gw, int NGW) {
    const float* XW = (const float*)(ws + WS_XW); const float* gn = (const float*)(ws + WS_PRM) + PRM_NFIN;
    f32x4 g4[4];
#pragma unroll
    for (int j = 0; j < 4; ++j) g4[j] = *(const f32x4*)(gn + 4 * lane + 256 * j);
    for (int m = gw; m < ML; m += NGW) {
        f32x4 v[4]; float s = 0.f;
#pragma unroll
        for (int j = 0; j < 4; ++j) { v[j] = *(const f32x4*)(XW + (size_t)m * D + 4 * lane + 256 * j); s += (v[j].x * v[j].x + v[j].y * v[j].y) + (v[j].z * v[j].z + v[j].w * v[j].w); }
        const float rstd = 1.0f / sqrtf(wave_sum(s, lane) * (1.f / D) + EPS);
#pragma unroll
        for (int j = 0; j < 4; ++j) *(f32x4*)(out + (size_t)m * D + 4 * lane + 256 * j) = (v[j] * rstd) * g4[j];
    }
}

__device__ __forceinline__ void mix_phase(unsigned char* ws, LAS unsigned char* lds, int j, int tid, int lane, int wave, int bid, int G) {
    const float* prm = (const float*)(ws + WS_PRM);
    const bf16* UQ = (const bf16*)(ws + WS_UQ); const bf16* GVT = (const bf16*)(ws + WS_GVT); bf16* Y = (bf16*)(ws + WS_Y);
    const float* stats = (const float*)(ws + WS_STATS); const bf16* WSb = (const bf16*)(ws + WS_WS);
    LAS float* st = (LAS float*)lds;
    const int li = lane & 15, gq = lane >> 4;
    for (int u = bid; u < 136 * 4; u += G) {
        const int chunk = u >> 2, g = u & 3, token0 = chunk * 128;
        int s0, L, seqbase;
        if (chunk < 128) { s0 = (chunk & 31) * 128; L = SEQ; seqbase = (chunk >> 5) * SEQ; } else { const int cc = chunk - 128; s0 = (cc & 1) * 128; L = CTXL; seqbase = ML + (cc >> 1) * CTXL; }
        __syncthreads();
        if (tid < 128) { const float* p = stats + (size_t)(token0 + tid) * 8; const f32x4 p0 = *(const f32x4*)p, p1 = *(const f32x4*)(p + 4);
            const float S = (p0.x + p0.z) + (p1.x + p1.z), Q = (p0.y + p0.w) + (p1.y + p1.w);
            const float mean = S * (1.f / 512.f); const float var = fmaxf(Q * (1.f / 512.f) - mean * mean, 0.f);
            st[2 * tid] = mean; st[2 * tid + 1] = 1.0f / sqrtf(var + EPS); }
        __syncthreads();
        {
            const int c = 16 * wave + li;
            const float lnv = prm[PRM_LNV + j * 512 + g * 128 + c];
            f32x4 acc[8];
#pragma unroll
            for (int ib = 0; ib < 8; ++ib) acc[ib] = (f32x4){0.f, 0.f, 0.f, 0.f};
#pragma unroll
            for (int ks = 0; ks < 4; ++ks) {
                const v4u raw = *(const v4u*)(GVT + (size_t)(g * 128 + c) * MA + token0 + 32 * ks + 8 * gq);
                const LAS f32x4* sp = (const LAS f32x4*)(st + 2 * (32 * ks + 8 * gq));
                const f32x4 m0 = sp[0], m1 = sp[1], m2 = sp[2], m3 = sp[3];
                v4u an;
                an.x = pk2((bf2f(raw.x & 0xffffu) - m0.x) * m0.y * lnv, (bf2f(raw.x >> 16) - m0.z) * m0.w * lnv);
                an.y = pk2((bf2f(raw.y & 0xffffu) - m1.x) * m1.y * lnv, (bf2f(raw.y >> 16) - m1.z) * m1.w * lnv);
                an.z = pk2((bf2f(raw.z & 0xffffu) - m2.x) * m2.y * lnv, (bf2f(raw.z >> 16) - m2.z) * m2.w * lnv);
                an.w = pk2((bf2f(raw.w & 0xffffu) - m3.x) * m3.y * lnv, (bf2f(raw.w >> 16) - m3.z) * m3.w * lnv);
                const bf16x8 af = __builtin_bit_cast(bf16x8, an);
#pragma unroll
                for (int ib = 0; ib < 8; ++ib) {
                    const bf16x8 bfr = *(const bf16x8*)(WSb + ((size_t)((j * 4 + g) * 128 + 16 * ib + li)) * 128 + 32 * ks + 8 * gq);
                    acc[ib] = __builtin_amdgcn_mfma_f32_16x16x32_bf16(af, bfr, acc[ib], 0, 0, 0); }
            }
            const int cc = g * 128 + 16 * wave + 4 * gq;
#pragma unroll
            for (int ib = 0; ib < 8; ++ib) {
                const int tok = token0 + 16 * ib + li;
                const float bs = prm[PRM_BS + (j * 4 + g) * 128 + 16 * ib + li];
                const v2u uu = *(const v2u*)(UQ + (size_t)tok * 1024 + cc);
                v2u o; o.x = pk2(bf2f(uu.x & 0xffffu) * (acc[ib][0] + bs), bf2f(uu.x >> 16) * (acc[ib][1] + bs));
                o.y = pk2(bf2f(uu.y & 0xffffu) * (acc[ib][2] + bs), bf2f(uu.y >> 16) * (acc[ib][3] + bs));
                *(v2u*)(Y + (size_t)tok * 1024 + cc) = o; }
        }
        {
            const int c8 = tid & 15, rg = tid >> 4, hw = 1 << g;
            const int t0 = s0 + 4 * rg;
            const int rlo = max(t0 - hw, 0), rhi = min(t0 + 3 + hw, L);
            float sum[4][8], self[4][8];
#pragma unroll
            for (int tt = 0; tt < 4; ++tt)
#pragma unroll
                for (int e = 0; e < 8; ++e) { sum[tt][e] = 0.f; self[tt][e] = 0.f; }
            const bf16* qb = UQ + (size_t)seqbase * 1024 + 512 + g * 128 + c8 * 8;
            for (int r = rlo; r < rhi; ++r) {
                const v4u raw = *(const v4u*)(qb + (size_t)r * 1024);
                float f[8]; f[0] = bf2f(raw.x & 0xffffu); f[1] = bf2f(raw.x >> 16); f[2] = bf2f(raw.y & 0xffffu); f[3] = bf2f(raw.y >> 16);
                f[4] = bf2f(raw.z & 0xffffu); f[5] = bf2f(raw.z >> 16); f[6] = bf2f(raw.w & 0xffffu); f[7] = bf2f(raw.w >> 16);
#pragma unroll
                for (int tt = 0; tt < 4; ++tt) { const int t = t0 + tt; const bool in = (r >= t - hw) && (r < t + hw); const bool me = (r == t);
#pragma unroll
                    for (int e = 0; e < 8; ++e) { sum[tt][e] += in ? f[e] : 0.f; self[tt][e] = me ? f[e] : self[tt][e]; } }
            }
#pragma unroll
            for (int tt = 0; tt < 4; ++tt) { const int t = t0 + tt; const int lo = max(t - hw, 0), hi = min(t + hw, L); const float inv = 1.0f / (float)(hi - lo);
                v4u o; o.x = pk2(sum[tt][0] * inv - self[tt][0], sum[tt][1] * inv - self[tt][1]); o.y = pk2(sum[tt][2] * inv - self[tt][2], sum[tt][3] * inv - self[tt][3]);
                o.z = pk2(sum[tt][4] * inv - self[tt][4], sum[tt][5] * inv - self[tt][5]); o.w = pk2(sum[tt][6] * inv - self[tt][6], sum[tt][7] * inv - self[tt][7]);
                *(v4u*)(Y + (size_t)(seqbase + t) * 1024 + 512 + g * 128 + c8 * 8) = o; }
        }
    }
}

template <bool CTXQ>
__device__ __forceinline__ void attn_wave(const bf16* QK, const bf16* VT, bf16* O, const LAS float* rpbL, int b, int h, int r, int jg, int qtok0, int lane) {
    const int li = lane & 15, gq = lane >> 4;
    constexpr int NCH = CTXQ ? 8 : 16, NNB = CTXQ ? 0 : 8;
    bf16x8 qf[2];
    { const bf16* qp = QK + (size_t)(qtok0 + li) * 2048 + h * 64 + 8 * gq; qf[0] = *(const bf16x8*)qp; qf[1] = *(const bf16x8*)(qp + 32); }
    const int kwin0 = jg == 0 ? 0 : (jg == 1 ? 8 : (jg == 2 ? 24 : 32));
    const int rs = min(max(r - 4, 0), 56);
    const int kofs = (li >> 2) * 8 + (li & 3);
    const int nbbase = b * SEQ + rs * 64 + kwin0, cxbase = ML + b * CTXL;
    f32x4 s[NCH][2];
#pragma unroll
    for (int ch = 0; ch < NCH; ++ch) {
        const int base = ch < NNB ? nbbase + ch * 64 : cxbase + 32 * (ch - NNB);
#pragma unroll
        for (int t = 0; t < 2; ++t) {
            const bf16* kp = QK + (size_t)(base + kofs + 4 * t) * 2048 + 1024 + h * 64 + 8 * gq;
            const bf16x8 k0 = *(const bf16x8*)kp, k1 = *(const bf16x8*)(kp + 32);
            f32x4 c = (f32x4){0.f, 0.f, 0.f, 0.f};
            c = __builtin_amdgcn_mfma_f32_16x16x32_bf16(k0, qf[0], c, 0, 0, 0);
            c = __builtin_amdgcn_mfma_f32_16x16x32_bf16(k1, qf[1], c, 0, 0, 0);
            s[ch][t] = c; }
    }
    if (!CTXQ) {
        const int cq = 16 * jg + li, cs = min(max(cq - 8, 0), 48);
#pragma unroll
        for (int ch = 0; ch < NNB; ++ch) { const int dr = rs + ch - r + 7;
#pragma unroll
            for (int t = 0; t < 2; ++t)
#pragma unroll
                for (int e = 0; e < 4; ++e) { const int kc = kwin0 + 8 * gq + 4 * t + e; const bool valid = (kc >= cs) && (kc < cs + 16);
                    const int dc = min(max(kc - cq + 15, 0), 30); const float bias = rpbL[dr * 31 + dc];
                    s[ch][t][e] = valid ? s[ch][t][e] + bias : -1e30f; } }
    }
    float mx = -1e30f;
#pragma unroll
    for (int ch = 0; ch < NCH; ++ch)
#pragma unroll
        for (int t = 0; t < 2; ++t)
#pragma unroll
            for (int e = 0; e < 4; ++e) mx = fmaxf(mx, s[ch][t][e]);
    mx = fmaxf(mx, pg8::xshfl<16>(mx)); mx = fmaxf(mx, pg8::xshfl32(mx, lane));
    float lsum = 0.f; bf16x8 pf[NCH];
#pragma unroll
    for (int ch = 0; ch < NCH; ++ch) { float p[8];
#pragma unroll
        for (int t = 0; t < 2; ++t)
#pragma unroll
            for (int e = 0; e < 4; ++e) { p[4 * t + e] = __builtin_amdgcn_exp2f(s[ch][t][e] - mx); lsum += p[4 * t + e]; }
        v4u w; w.x = pk2(p[0], p[1]); w.y = pk2(p[2], p[3]); w.z = pk2(p[4], p[5]); w.w = pk2(p[6], p[7]);
        pf[ch] = __builtin_bit_cast(bf16x8, w); }
    lsum += pg8::xshfl<16>(lsum); lsum += pg8::xshfl32(lsum, lane);
    const float inv = 1.0f / lsum;
#pragma unroll
    for (int db = 0; db < 4; ++db) {
        f32x4 o = (f32x4){0.f, 0.f, 0.f, 0.f};
        const bf16* vrow = VT + (size_t)(h * 64 + 16 * db + li) * MA + 8 * gq;
#pragma unroll
        for (int ch = 0; ch < NCH; ++ch) { const int base = ch < NNB ? nbbase + ch * 64 : cxbase + 32 * (ch - NNB);
            const bf16x8 vf = *(const bf16x8*)(vrow + base);
            o = __builtin_amdgcn_mfma_f32_16x16x32_bf16(vf, pf[ch], o, 0, 0, 0); }
        v2u w; w.x = pk2(o[0] * inv, o[1] * inv); w.y = pk2(o[2] * inv, o[3] * inv);
        *(v2u*)(O + (size_t)(qtok0 + li) * 1024 + h * 64 + 16 * db + 4 * gq) = w; }
}

__device__ __forceinline__ void attn_phase(unsigned char* ws, LAS unsigned char* lds, int j, bool ctxq, int tid, int lane, int wave, int bid, int G) {
    const bf16* QK = (const bf16*)(ws + WS_QK); const bf16* VT = (const bf16*)(ws + WS_VT); bf16* O = (bf16*)(ws + WS_O);
    LAS float* rpbL = (LAS float*)lds;
    for (int u = bid; u < 2048; u += G) {
        const int x = u & 7, within = u >> 3, bh = x * 8 + (within >> 5), rp = within & 31, b = bh >> 4, h = bh & 15;
        __syncthreads();
        if (tid < 465) rpbL[tid] = ((const float*)(ws + WS_PRM))[PRM_RPB + (j * 16 + h) * 465 + tid];
        __syncthreads();
        const int r = 2 * rp + (wave >> 2), jg = wave & 3;
        attn_wave<false>(QK, VT, O, rpbL, b, h, r, jg, b * SEQ + r * 64 + 16 * jg, lane);
    }
    if (ctxq) for (int u = bid; u < 128; u += G) {
        const int bh = u >> 1, part = u & 1, b = bh >> 4, h = bh & 15;
        attn_wave<true>(QK, VT, O, rpbL, b, h, 0, 0, ML + b * CTXL + 128 * part + 16 * wave, lane);
    }
}

__global__ void __launch_bounds__(NT, 2) mega(Args a) {
    extern __shared__ __attribute__((aligned(16))) unsigned char lds_raw[];
    LAS unsigned char* lds = (LAS unsigned char*)lds_raw;
    cg::grid_group grid = cg::this_grid();
    const int G = gridDim.x, bid = blockIdx.x;
    const int vcu = (G % 8 == 0) ? (bid % 8) * (G / 8) + bid / 8 : bid;
    const int NGW = G * NWAVES;
#define TIDS() int tid = threadIdx.x; asm volatile("" : "+v"(tid)); const int lane = tid & 63, wave = __builtin_amdgcn_readfirstlane(tid >> 6), gw = vcu * NWAVES + wave; (void)lane; (void)gw
    unsigned char* ws = a.ws; float* out = a.out;
    bf16* HN = (bf16*)(ws + WS_HN);
    const float* MOD = (const float*)(ws + WS_MOD);

    { TIDS(); prologue(a, lds, tid, lane, wave, bid, G, gw, NGW); }
    grid.sync();
#pragma unroll 1
    for (int i = 0; i < 4; ++i) {
        const bool odd = (i & 1) != 0, last = (i == 3); const int j = i >> 1; const int Mact = last ? ML : MA;
        { TIDS(); rowpass(ws, i, 0, MA, lane, gw, NGW); }
        grid.sync();
        if (odd) {
            { pg8::Gemm g{HN, (const bf16*)(ws + WS_WQKV) + (size_t)j * 3072 * 1024, MA, 2048, 1024}; pg8::StaticOrder S; S.init(MA, 2048, G, bid);
              pg8::EpiStoreBf16 E{(bf16*)(ws + WS_QK), 2048, 0, 4, 0.125f * LOG2E};
              pg8::gemm_phase<pg8::EpiStoreBf16, pg8::StaticOrder, true, true>(lds, g, S, E); }
            { pg8::Gemm g{(const bf16*)(ws + WS_WQKV) + (size_t)j * 3072 * 1024 + (size_t)2048 * 1024, HN, 1024, MA, 1024}; pg8::StaticOrder S; S.init(1024, MA, G, bid);
              pg8::EpiStoreBf16 E{(bf16*)(ws + WS_VT), MA, 0, 0, 1.f};
              pg8::gemm_phase<pg8::EpiStoreBf16, pg8::StaticOrder, true, true>(lds, g, S, E); }
        } else {
            { pg8::Gemm g{HN, (const bf16*)(ws + WS_WIN) + (size_t)j * 1536 * 1024, MA, 1024, 1024}; pg8::StaticOrder S; S.init(MA, 1024, G, bid);
              pg8::EpiStoreBf16 E{(bf16*)(ws + WS_UQ), 1024, 2, 0, 1.f};
              pg8::gemm_phase<pg8::EpiStoreBf16, pg8::StaticOrder, true, true>(lds, g, S, E); }
            { pg8::Gemm g{(const bf16*)(ws + WS_WIN) + (size_t)j * 1536 * 1024 + (size_t)1024 * 1024, HN, 512, MA, 1024}; pg8::StaticOrder S; S.init(512, MA, G, bid);
              pg8::EpiGVt E{(bf16*)(ws + WS_GVT), MA, (float*)(ws + WS_STATS)};
              pg8::gemm_phase<pg8::EpiGVt, pg8::StaticOrder, true, true>(lds, g, S, E); }
        }
        grid.sync();
        if (odd) { TIDS(); attn_phase(ws, lds, j, !last, tid, lane, wave, bid, G); }
        else { TIDS(); mix_phase(ws, lds, j, tid, lane, wave, bid, G); }
        grid.sync();
        { pg8::Gemm g{odd ? (const bf16*)(ws + WS_O) : (const bf16*)(ws + WS_Y), odd ? (const bf16*)(ws + WS_WONA) + (size_t)j * 1024 * 1024 : (const bf16*)(ws + WS_WOAB) + (size_t)j * 1024 * 1024, Mact, 1024, 1024};
          pg8::StaticOrder S; S.init(Mact, 1024, G, bid);
          pg8::EpiResGate E{(float*)(ws + WS_XW), MOD + (size_t)i * 5 * 6144 + 2 * 1024};
          pg8::gemm_phase<pg8::EpiResGate, pg8::StaticOrder, true, true>(lds, g, S, E); }
        grid.sync();
        { TIDS(); rowpass(ws, i, 1, Mact, lane, gw, NGW); }
        grid.sync();
        { pg8::Gemm g{HN, (const bf16*)(ws + WS_WFI) + (size_t)i * NFI * 1024, Mact, NFI, 1024}; pg8::StaticOrder S; S.init(Mact, NFI, G, bid);
          pg8::EpiSwiGLU E{(bf16*)(ws + WS_H2), DFF};
          pg8::gemm_phase<pg8::EpiSwiGLU, pg8::StaticOrder, true, true>(lds, g, S, E); }
        grid.sync();
        { pg8::Gemm g{(const bf16*)(ws + WS_H2), (const bf16*)(ws + WS_WFO) + (size_t)i * 1024 * DFF, Mact, 1024, DFF}; pg8::StaticOrder S; S.init(Mact, 1024, G, bid);
          pg8::EpiResGate E{(float*)(ws + WS_XW), MOD + (size_t)i * 5 * 6144 + 5 * 1024};
          pg8::gemm_phase<pg8::EpiResGate, pg8::StaticOrder, true, true>(lds, g, S, E); }
        grid.sync();
    }
    { TIDS(); final_norm(ws, out, lane, gw, NGW); }
}

extern "C" void kernel_launch(void* const* d_in, const int* in_sizes, int n_in, void* d_out, int out_size, void* d_ws, size_t ws_size, hipStream_t stream) {
    static int grid = 0;
    if (grid == 0) {
        if (n_in != 21 || ws_size < WS_END) { fprintf(stderr, "kernel_launch: expected 21 inputs and >= %zu bytes of workspace (got %d, %zu)\n", (size_t)WS_END, n_in, ws_size); grid = -1; return; }
        int dev = 0, cus = 0, per_cu = 0;
        (void)hipGetDevice(&dev); (void)hipDeviceGetAttribute(&cus, hipDeviceAttributeMultiprocessorCount, dev);
        if (hipFuncSetAttribute((const void*)mega, hipFuncAttributeMaxDynamicSharedMemorySize, LDS_BYTES) != hipSuccess) fprintf(stderr, "kernel_launch: hipFuncSetAttribute failed\n");
        if (hipOccupancyMaxActiveBlocksPerMultiprocessor(&per_cu, (const void*)mega, NT, LDS_BYTES) != hipSuccess || per_cu < 1) { fprintf(stderr, "kernel_launch: occupancy query says %d\n", per_cu); per_cu = 1; }
        (void)hipGetLastError();
        grid = cus > 0 ? cus : 256;
    }
    if (grid < 0) return;
    Args a{};
    for (int i = 0; i < 21; ++i) a.in[i] = (const float*)d_in[i];
    a.out = (float*)d_out; a.ws = (unsigned char*)d_ws;
    void* args[] = {&a};
    hipError_t e = hipLaunchCooperativeKernel((const void*)mega, dim3(grid), dim3(NT), args, LDS_BYTES, stream);
    if (e != hipSuccess) fprintf(stderr, "kernel_launch: cooperative launch failed: %s (grid %d)\n", hipGetErrorString(e), grid);
}
```

```cpp
#include <hip/hip_runtime.h>
#include <hip/hip_cooperative_groups.h>
#include <cstdio>
#include <cstdint>
namespace cg = cooperative_groups;
namespace pg8 {
#define PG8_LAS __attribute__((address_space(3)))
typedef unsigned short bf16_t;
typedef short bf16x8 __attribute__((ext_vector_type(8)));
typedef float f32x4 __attribute__((ext_vector_type(4)));
typedef unsigned u32x4 __attribute__((ext_vector_type(4)));
constexpr int BM = 256, BK = 64, HALF = 128, HTB = HALF * BK * 2  , STAGE_BYTES = 8 * HTB, NXCD = 8, WGM = 8;

__host__ __device__ __forceinline__ int lds_byte(int r, int c) { const int st = (r >> 4) * 2 + (c >> 5), rr = r & 15, cc = c & 31, ob = rr * 64 + cc * 2; return st * 1024 + (ob ^ (((ob >> 9) & 1) << 5)); }
__host__ __device__ __forceinline__ void stage_rc(int b, int& R, int& C) { const int st = b / 1024, sb = b % 1024, swz = sb ^ (((sb >> 9) & 1) << 5); R = (st >> 1) * 16 + swz / 64; C = (st & 1) * 32 + (swz % 64) / 2; }
__host__ __device__ __forceinline__ int perm32(int rho) { const int n = rho >> 4, i = rho & 15; return 8 * (i >> 2) + 4 * n + (i & 3); }

struct Unit { int pm, pn; };
struct Gemm { const bf16_t* A; const bf16_t* Bt; int M, N, K; };

struct StaticOrder {
    int nM, nN, nwg, G, c;
    __host__ __device__ void init(int M, int N, int G_, int c_) { nM = M / BM; nN = N / BM; nwg = nM * nN; G = G_; c = c_; }
    __host__ __device__ bool next(int i, Unit& u) const {
        const long L = (long)i * G + c; if (L >= nwg) return false;
        int wgid = (int)L; { const int q = nwg / NXCD, r = nwg % NXCD, xcd = wgid % NXCD, off = wgid / NXCD; wgid = (xcd < r ? xcd * (q + 1) : r * (q + 1) + (xcd - r) * q) + off; }
        const int nig = WGM * nN, gid = wgid / nig, fm = gid * WGM, gsz = (nM - fm) < WGM ? (nM - fm) : WGM;
        u.pm = fm + ((wgid % nig) % gsz); u.pn = (wgid % nig) / gsz; return true;
    }
    __device__ __forceinline__ void a_ready(const Unit&) const {}
    __device__ __forceinline__ void done(const Unit&) const {}
};

__device__ __forceinline__ unsigned cvt_pk_bf16(float lo, float hi) { unsigned r; asm volatile("v_cvt_pk_bf16_f32 %0, %1, %2" : "=v"(r) : "v"(lo), "v"(hi)); return r; }
typedef float f32x2 __attribute__((ext_vector_type(2)));
__device__ __forceinline__ float gelu_tanh_f(float x) {
    const float y = x * (0.7978845608f + 0.0356774081f * x * x);
    const float e = __builtin_amdgcn_exp2f(-2.885390082f * y);
    return x * __builtin_amdgcn_rcpf(1.0f + e);
}
template <int O> __device__ __forceinline__ float xshfl(float v) { static_assert(O < 32, "xshfl<O>: O < 32"); return __uint_as_float((unsigned)__builtin_amdgcn_ds_swizzle((int)__float_as_uint(v), (O << 10) | 0x1f)); }
__device__ __forceinline__ float xshfl32(float v, int lane) { return __uint_as_float((unsigned)__builtin_amdgcn_ds_bpermute((lane ^ 32) << 2, (int)__float_as_uint(v))); }
__device__ __forceinline__ float silu_f(float x) { return x * __builtin_amdgcn_rcpf(1.0f + __builtin_amdgcn_exp2f(-1.4426950409f * x)); }

struct EpiStoreBf16 {
    static constexpr bool PERM = true, AFTER_DRAIN = false;
    bf16_t* O; int ldc; int gelu_pn_lt; int scale_pn_lt; float scale0;
    __device__ __forceinline__ void operator()(const f32x4 (&acc)[2][2][4][2], const Unit& u, int wr, int wc, int fr, int fq) const {
        const int row0 = u.pm * BM + wr * 64 + fr; const int col0 = u.pn * BM + wc * 32 + 8 * fq;
        const bool act = u.pn < gelu_pn_lt; const float sc = (u.pn < scale_pn_lt) ? scale0 : 1.f;
#pragma unroll
        for (int ai = 0; ai < 2; ++ai)
#pragma unroll
            for (int m = 0; m < 4; ++m) { bf16_t* rowp = O + (size_t)(row0 + ai * HALF + m * 16) * ldc + col0;
#pragma unroll
                for (int bj = 0; bj < 2; ++bj) { f32x4 v0 = acc[ai][bj][m][0], v1 = acc[ai][bj][m][1];
                    if (act) {
#pragma unroll
                        for (int e = 0; e < 4; ++e) { v0[e] = gelu_tanh_f(v0[e]); v1[e] = gelu_tanh_f(v1[e]); } }
                    v0 = v0 * sc; v1 = v1 * sc; u32x4 w; w.x = cvt_pk_bf16(v0[0], v0[1]); w.y = cvt_pk_bf16(v0[2], v0[3]); w.z = cvt_pk_bf16(v1[0], v1[1]); w.w = cvt_pk_bf16(v1[2], v1[3]);
                    *(u32x4*)(rowp + bj * HALF) = w; } }
    }
};

struct EpiGVt {
    static constexpr bool PERM = true, AFTER_DRAIN = false;
    bf16_t* O; int ldc; float* stats;
    __device__ __forceinline__ void operator()(const f32x4 (&acc)[2][2][4][2], const Unit& u, int wr, int wc, int fr, int fq) const {
        const int row0 = u.pm * BM + wr * 64 + fr; const int col0 = u.pn * BM + wc * 32 + 8 * fq;
        const int slot = u.pm * 2 + wr;
#pragma unroll
        for (int bj = 0; bj < 2; ++bj) {
            float s[2][4], q[2][4];
#pragma unroll
            for (int n = 0; n < 2; ++n)
#pragma unroll
                for (int e = 0; e < 4; ++e) { s[n][e] = 0.f; q[n][e] = 0.f; }
#pragma unroll
            for (int ai = 0; ai < 2; ++ai)
#pragma unroll
                for (int m = 0; m < 4; ++m) { bf16_t* rowp = O + (size_t)(row0 + ai * HALF + m * 16) * ldc + col0;
                    f32x4 v0 = acc[ai][bj][m][0], v1 = acc[ai][bj][m][1];
#pragma unroll
                    for (int e = 0; e < 4; ++e) { v0[e] = gelu_tanh_f(v0[e]); v1[e] = gelu_tanh_f(v1[e]);
                        s[0][e] += v0[e]; q[0][e] += v0[e] * v0[e]; s[1][e] += v1[e]; q[1][e] += v1[e] * v1[e]; }
                    u32x4 w; w.x = cvt_pk_bf16(v0[0], v0[1]); w.y = cvt_pk_bf16(v0[2], v0[3]); w.z = cvt_pk_bf16(v1[0], v1[1]); w.w = cvt_pk_bf16(v1[2], v1[3]);
                    *(u32x4*)(rowp + bj * HALF) = w; }
#pragma unroll
            for (int n = 0; n < 2; ++n)
#pragma unroll
                for (int e = 0; e < 4; ++e) { float a = s[n][e], b = q[n][e];
                    a += xshfl<1>(a); b += xshfl<1>(b); a += xshfl<2>(a); b += xshfl<2>(b); a += xshfl<4>(a); b += xshfl<4>(b); a += xshfl<8>(a); b += xshfl<8>(b);
                    if (fr == 0) { float* p = stats + ((size_t)(col0 + bj * HALF + 4 * n + e) * 4 + slot) * 2; p[0] = a; p[1] = b; } }
            asm volatile("" ::: "memory");
        }
    }
};

struct EpiResGate {
    static constexpr bool PERM = false, AFTER_DRAIN = false;
    float* X; const float* gate_base;
    __device__ __forceinline__ void operator()(const f32x4 (&acc)[2][2][4][2], const Unit& u, int wr, int wc, int fr, int fq) const {
        const int cond = u.pm < 64 ? (u.pm >> 4) : 4; const float* gate = gate_base + cond * 6144;
        const int col0 = u.pn * BM + wc * 32 + 4 * fq;
        f32x4 gv[2][2];
#pragma unroll
        for (int bj = 0; bj < 2; ++bj)
#pragma unroll
            for (int n = 0; n < 2; ++n) gv[bj][n] = *(const f32x4*)(gate + col0 + bj * HALF + n * 16);
#pragma unroll
        for (int ai = 0; ai < 2; ++ai)
#pragma unroll
            for (int m = 0; m < 4; ++m) { float* rowp = X + (size_t)(u.pm * BM + ai * HALF + wr * 64 + m * 16 + fr) * 1024 + col0;
#pragma unroll
                for (int bj = 0; bj < 2; ++bj)
#pragma unroll
                    for (int n = 0; n < 2; ++n) { f32x4* p = (f32x4*)(rowp + bj * HALF + n * 16); *p = *p + gv[bj][n] * acc[ai][bj][m][n]; } }
    }
};

struct EpiSwiGLU {
    static constexpr bool PERM = true, AFTER_DRAIN = false;
    bf16_t* O; int ldc;
    __device__ __forceinline__ void operator()(const f32x4 (&acc)[2][2][4][2], const Unit& u, int wr, int wc, int fr, int fq) const {
        const int row0 = u.pm * BM + wr * 64 + fr; const int col0 = u.pn * HALF + wc * 32 + 8 * fq;
#pragma unroll
        for (int ai = 0; ai < 2; ++ai)
#pragma unroll
            for (int m = 0; m < 4; ++m) { bf16_t* rowp = O + (size_t)(row0 + ai * HALF + m * 16) * ldc + col0;
                f32x4 v0, v1;
#pragma unroll
                for (int e = 0; e < 4; ++e) { v0[e] = silu_f(acc[ai][0][m][0][e]) * acc[ai][1][m][0][e]; v1[e] = silu_f(acc[ai][0][m][1][e]) * acc[ai][1][m][1][e]; }
                u32x4 w; w.x = cvt_pk_bf16(v0[0], v0[1]); w.y = cvt_pk_bf16(v0[2], v0[3]); w.z = cvt_pk_bf16(v1[0], v1[1]); w.w = cvt_pk_bf16(v1[2], v1[3]);
                *(u32x4*)rowp = w; }
    }
};

template <class Epi, class Sched, bool ALIGN_EPI = false, bool SP2 = false>
__device__ __forceinline__ void gemm_phase(PG8_LAS unsigned char* lds, const Gemm g, const Sched& S, const Epi& E) {
    int tid_l = threadIdx.x; asm volatile("" : "+v"(tid_l));
    const int tid = tid_l, wid = __builtin_amdgcn_readfirstlane(tid >> 6), lane = tid & 63, wr = wid >> 2, wc = wid & 3, fr = lane & 15, fq = lane >> 4;
    const int K = g.K, nt = K / BK;
    unsigned voffA[2], voffB[2];
#pragma unroll
    for (int i = 0; i < 2; ++i) { int R, C; stage_rc(tid * 16 + i * 8192, R, C); const int Rb = Epi::PERM ? ((R & ~31) + perm32(R & 31)) : R;
        voffA[i] = (unsigned)(R * K + C) * 2u; voffB[i] = (unsigned)(Rb * K + C) * 2u; }
    const size_t kstep = (size_t)(BK * 2);
    const size_t hstep = (size_t)HALF * K * 2;
    const size_t tstep = 2 * hstep;
    const unsigned ldsw = (unsigned)wid * 1024u;
    const int aoff = lds_byte(wr * 64 + fr, fq * 8), boff = lds_byte(wc * 32 + fr, fq * 8);
#define PG8_SA(b, h) (((b) * 2 + (h)) * HTB)
#define PG8_SB(b, h) ((4 + (b) * 2 + (h)) * HTB)
#define PG8_STAGE(bufoff, gbase, voff) do { _Pragma("unroll") for (int _i = 0; _i < 2; ++_i) \
        __builtin_amdgcn_global_load_lds((const unsigned*)((const char*)(gbase) + (voff)[_i]), (PG8_LAS unsigned*)(lds + (bufoff) + ldsw + _i * 8192), 16, 0, 0); } while (0)
#define PG8_LDA(dst, b, h) do { _Pragma("unroll") for (int m = 0; m < 4; ++m) _Pragma("unroll") for (int k = 0; k < 2; ++k) dst[m][k] = *(const PG8_LAS bf16x8*)(lds + PG8_SA(b, h) + aoff + m * 2048 + k * 1024); } while (0)
#define PG8_LDB(dst, b, h) do { _Pragma("unroll") for (int n = 0; n < 2; ++n) _Pragma("unroll") for (int k = 0; k < 2; ++k) dst[n][k] = *(const PG8_LAS bf16x8*)(lds + PG8_SB(b, h) + boff + n * 2048 + k * 1024); } while (0)
#define PG8_MMA(ai, bj, At, Bt) do { __builtin_amdgcn_s_setprio(1); _Pragma("unroll") for (int m = 0; m < 4; ++m) _Pragma("unroll") for (int n = 0; n < 2; ++n) _Pragma("unroll") for (int k = 0; k < 2; ++k) \
        acc[ai][bj][m][n] = __builtin_amdgcn_mfma_f32_16x16x32_bf16(Bt[n][k], At[m][k], acc[ai][bj][m][n], 0, 0, 0); __builtin_amdgcn_s_setprio(0); } while (0)
#define PG8_WAIT_V(n) asm volatile("s_waitcnt vmcnt(" #n ")" ::: "memory")
#define PG8_WAIT_L(n) asm volatile("s_waitcnt lgkmcnt(" #n ")" ::: "memory")
#define PG8_BAR __builtin_amdgcn_s_barrier()
#define PG8_SCHED __builtin_amdgcn_sched_barrier(0)
    Unit cur, nxt; int ui = 0;
    if (!S.next(0, cur)) return;
    f32x4 acc[2][2][4][2];
#pragma unroll
    for (int a = 0; a < 2; ++a)
#pragma unroll
        for (int b = 0; b < 2; ++b)
#pragma unroll
            for (int m = 0; m < 4; ++m)
#pragma unroll
                for (int n = 0; n < 2; ++n) acc[a][b][m][n] = (f32x4){0.f, 0.f, 0.f, 0.f};
    bf16x8 At[4][2], B0[2][2], B1[2][2];
    const char* cA = (const char*)g.A + (size_t)cur.pm * tstep; const char* cB = (const char*)g.Bt + (size_t)cur.pn * tstep;
    S.a_ready(cur);
    if constexpr (SP2) {
        PG8_STAGE(PG8_SB(0, 0), cB, voffB); PG8_STAGE(PG8_SB(0, 1), cB + hstep, voffB); PG8_STAGE(PG8_SA(0, 0), cA, voffA); PG8_STAGE(PG8_SA(0, 1), cA + hstep, voffA);
        if (wr == 1) PG8_BAR;
        PG8_WAIT_V(2); PG8_BAR;
        PG8_STAGE(PG8_SB(1, 0), cB + kstep, voffB); PG8_STAGE(PG8_SA(1, 0), cA + kstep, voffA); PG8_STAGE(PG8_SB(1, 1), cB + hstep + kstep, voffB);
        PG8_WAIT_V(6); PG8_BAR;
    } else {
        PG8_STAGE(PG8_SB(0, 0), cB, voffB); PG8_STAGE(PG8_SA(0, 0), cA, voffA); PG8_STAGE(PG8_SB(0, 1), cB + hstep, voffB); PG8_STAGE(PG8_SA(0, 1), cA + hstep, voffA);
        if (wr == 1) PG8_BAR;
        PG8_WAIT_V(4); PG8_BAR;
        PG8_STAGE(PG8_SB(1, 0), cB + kstep, voffB); PG8_STAGE(PG8_SA(1, 0), cA + kstep, voffA); PG8_STAGE(PG8_SB(1, 1), cB + hstep + kstep, voffB);
        PG8_WAIT_V(6); PG8_BAR;
    }
    for (;;) {
        const bool has_next = S.next(ui + 1, nxt);
        const char* nA = has_next ? (const char*)g.A + (size_t)nxt.pm * tstep : cA; const char* nB = has_next ? (const char*)g.Bt + (size_t)nxt.pn * tstep : cB;
        for (int t = 0; t < nt; t += 2) {
            const bool last = (t == nt - 2);
            const char* a1 = cA + (size_t)(t + 1) * kstep;
            const char* a2 = last ? nA : cA + (size_t)(t + 2) * kstep; const char* b2 = last ? nB : cB + (size_t)(t + 2) * kstep;
            const char* a3 = a2 + kstep; const char* b3 = b2 + kstep;
            if (last && has_next) S.a_ready(nxt);
            if constexpr (SP2) {
            PG8_LDB(B0, 0, 0); PG8_LDB(B1, 0, 1); PG8_SCHED; PG8_LDA(At, 0, 0); PG8_STAGE(PG8_SA(1, 1), a1 + hstep, voffA);
            PG8_WAIT_V(8); PG8_WAIT_L(0); PG8_BAR; PG8_MMA(0, 0, At, B0); PG8_MMA(0, 1, At, B1); PG8_BAR; PG8_SCHED;
            PG8_LDA(At, 0, 1); PG8_STAGE(PG8_SB(0, 0), b2, voffB); PG8_STAGE(PG8_SB(0, 1), b2 + hstep, voffB); PG8_STAGE(PG8_SA(0, 0), a2, voffA);
            PG8_WAIT_V(8); PG8_WAIT_L(0); PG8_BAR; PG8_MMA(1, 0, At, B0); PG8_MMA(1, 1, At, B1); PG8_BAR; PG8_SCHED;
            PG8_LDB(B0, 1, 0); PG8_LDB(B1, 1, 1); PG8_SCHED; PG8_LDA(At, 1, 0); PG8_STAGE(PG8_SA(0, 1), a2 + hstep, voffA);
            PG8_WAIT_V(8); PG8_WAIT_L(0); PG8_BAR; PG8_MMA(0, 0, At, B0); PG8_MMA(0, 1, At, B1); PG8_BAR; PG8_SCHED;
            PG8_LDA(At, 1, 1); PG8_STAGE(PG8_SB(1, 0), b3, voffB); PG8_STAGE(PG8_SB(1, 1), b3 + hstep, voffB); PG8_STAGE(PG8_SA(1, 0), a3, voffA);
            PG8_WAIT_V(8); PG8_WAIT_L(0); PG8_BAR; PG8_MMA(1, 0, At, B0); PG8_MMA(1, 1, At, B1); PG8_BAR; PG8_SCHED;
            } else {
            PG8_LDB(B0, 0, 0); PG8_SCHED; PG8_LDA(At, 0, 0); PG8_STAGE(PG8_SA(1, 1), a1 + hstep, voffA);
            PG8_WAIT_L(8); PG8_BAR; PG8_WAIT_L(0); PG8_MMA(0, 0, At, B0); PG8_BAR; PG8_SCHED;
            PG8_LDB(B1, 0, 1); PG8_STAGE(PG8_SB(0, 0), b2, voffB);
            PG8_BAR; PG8_WAIT_L(0); PG8_MMA(0, 1, At, B1); PG8_BAR;
            PG8_LDA(At, 0, 1); PG8_STAGE(PG8_SA(0, 0), a2, voffA);
            PG8_BAR; PG8_WAIT_L(0); PG8_MMA(1, 0, At, B0); PG8_BAR; PG8_SCHED;
            PG8_STAGE(PG8_SB(0, 1), b2 + hstep, voffB);
            PG8_WAIT_V(6); PG8_BAR; PG8_MMA(1, 1, At, B1); PG8_BAR;
            PG8_LDB(B0, 1, 0); PG8_SCHED; PG8_LDA(At, 1, 0); PG8_STAGE(PG8_SA(0, 1), a2 + hstep, voffA);
            PG8_WAIT_L(8); PG8_BAR; PG8_WAIT_L(0); PG8_MMA(0, 0, At, B0); PG8_BAR; PG8_SCHED;
            PG8_LDB(B1, 1, 1); PG8_STAGE(PG8_SB(1, 0), b3, voffB);
            PG8_BAR; PG8_WAIT_L(0); PG8_MMA(0, 1, At, B1); PG8_BAR;
            PG8_LDA(At, 1, 1); PG8_STAGE(PG8_SA(1, 0), a3, voffA);
            PG8_BAR; PG8_WAIT_L(0); PG8_MMA(1, 0, At, B0); PG8_BAR; PG8_SCHED;
            PG8_STAGE(PG8_SB(1, 1), b3 + hstep, voffB);
            PG8_WAIT_V(6); PG8_BAR; PG8_MMA(1, 1, At, B1); PG8_BAR;
            }
        }
        if constexpr (ALIGN_EPI) { if (wr == 0) PG8_BAR; }
        if constexpr (!Epi::AFTER_DRAIN) { E(acc, cur, wr, wc, fr, fq); S.done(cur); }
        if (!has_next) break;
#pragma unroll
        for (int a = 0; a < 2; ++a)
#pragma unroll
            for (int b = 0; b < 2; ++b)
#pragma unroll
                for (int m = 0; m < 4; ++m)
#pragma unroll
                    for (int n = 0; n < 2; ++n) acc[a][b][m][n] = (f32x4){0.f, 0.f, 0.f, 0.f};
        cur = nxt; cA = nA; cB = nB; ++ui;
        if constexpr (ALIGN_EPI) { if (wr == 1) PG8_BAR; }
    }
    PG8_WAIT_V(0);
    if constexpr (!ALIGN_EPI) { if (wr == 0) PG8_BAR; }
    PG8_BAR;
    if constexpr (Epi::AFTER_DRAIN) { E.fused(acc, cur, wr, wc, fr, fq, lds, wid, lane); S.done(cur); }
#undef PG8_SA
#undef PG8_SB
#undef PG8_STAGE
#undef PG8_LDA
#undef PG8_LDB
#undef PG8_MMA
#undef PG8_WAIT_V
#undef PG8_WAIT_L
#undef PG8_BAR
#undef PG8_SCHED
}
}
#define LAS __attribute__((address_space(3)))
typedef unsigned short bf16;
typedef unsigned v4u __attribute__((ext_vector_type(4)));
typedef unsigned v2u __attribute__((ext_vector_type(2)));
typedef float f32x4 __attribute__((ext_vector_type(4)));
typedef short bf16x8 __attribute__((ext_vector_type(8)));

constexpr int NWAVES = 8, NT = 512;
constexpr int D = 1024, ML = 16384, MC = 1024, MA = ML + MC, SEQ = 4096, CTXL = 256, DFF = 2816, NFI = 2 * DFF;
constexpr float EPS = 1e-6f, LOG2E = 1.4426950408889634f;
constexpr size_t MiB = 1u << 20;
constexpr size_t WS_MOD = 1 * MiB;
constexpr size_t WS_STATS = 2 * MiB;
constexpr size_t WS_WS = 3 * MiB;
constexpr size_t WS_PRM = 3 * MiB + 512 * 1024;
constexpr int PRM_NMIX = 0, PRM_NFFN = 4096, PRM_LNV = 8192, PRM_BS = 9216, PRM_RPB = 10240, PRM_NFIN = 10240 + 14880, PRM_TOTAL = PRM_NFIN + 1024;
constexpr size_t WS_XW = 4 * MiB;
constexpr size_t WS_HN = 72 * MiB;
constexpr size_t WS_SCR = 106 * MiB;
constexpr size_t WS_H2 = WS_SCR;
constexpr size_t WS_QK = WS_SCR, WS_VT = WS_SCR + 68 * MiB, WS_O = WS_SCR + 102 * MiB;
constexpr size_t WS_UQ = WS_SCR, WS_GVT = WS_SCR + 34 * MiB, WS_Y = WS_SCR + 51 * MiB;
constexpr size_t WS_WIN = 242 * MiB;
constexpr size_t WS_WOAB = 248 * MiB;
constexpr size_t WS_WQKV = 252 * MiB;
constexpr size_t WS_WONA = 264 * MiB;
constexpr size_t WS_WFI = 268 * MiB;
constexpr size_t WS_WFO = 312 * MiB;
constexpr size_t WS_END = 334 * MiB;
constexpr int LDS_BYTES = 147456;

struct Args { const float* in[21]; float* out; unsigned char* ws; };

__device__ __forceinline__ float bf2f(unsigned b) { return __uint_as_float(b << 16); }
__device__ __forceinline__ unsigned pk2(float lo, float hi) { return pg8::cvt_pk_bf16(lo, hi); }
__device__ __forceinline__ float wave_sum(float v, int lane) {
    v += pg8::xshfl<1>(v); v += pg8::xshfl<2>(v); v += pg8::xshfl<4>(v); v += pg8::xshfl<8>(v); v += pg8::xshfl<16>(v); v += pg8::xshfl32(v, lane);
    return v;
}
#define LDS_WAIT() asm volatile("s_waitcnt lgkmcnt(0)" ::: "memory")

__device__ __forceinline__ void transpose_item(const float* W, int ldw, bf16* WT, int K, int k0, int n0, int drow0, LAS float* scr, int lane) {
#pragma unroll 8
    for (int i = 0; i < 32; ++i) { const int kk = 2 * i + (lane >> 5); scr[kk * 33 + (lane & 31)] = W[(size_t)(k0 + kk) * ldw + n0 + (lane & 31)]; }
    LDS_WAIT();
    const int c = lane & 7;
#pragma unroll
    for (int j = 0; j < 4; ++j) { const int n = (lane >> 3) + 8 * j; const LAS float* s = scr + (8 * c) * 33 + n;
        v4u o; o.x = pk2(s[0 * 33], s[1 * 33]); o.y = pk2(s[2 * 33], s[3 * 33]); o.z = pk2(s[4 * 33], s[5 * 33]); o.w = pk2(s[6 * 33], s[7 * 33]);
        *(v4u*)(WT + (size_t)(drow0 + n) * K + k0 + 8 * c) = o; }
    LDS_WAIT();
}

__device__ __forceinline__ void prologue(const Args& a, LAS unsigned char* lds, int tid, int lane, int wave, int bid, int G, int gw, int NGW) {
    unsigned char* ws = a.ws;
    {
        LAS float* scr = (LAS float*)(lds + wave * 16384);
        constexpr int I_IN = 16 * 32, I_SQ = 16 * 32, I_QKV = 16 * 96, I_FI = 16 * 176, I_FO = 44 * 32;
        constexpr int NITEMS = 2 * I_IN + 2 * I_SQ + 2 * I_QKV + 2 * I_SQ + 4 * I_FI + 4 * I_FO;
        for (int it = gw; it < NITEMS; it += NGW) {
            int r = it;
            if (r < 2 * I_IN) { const int j = r / I_IN; r -= j * I_IN; const int kb = r / 32, nb = r % 32, n0 = nb * 32;
                transpose_item(a.in[8] + (size_t)j * 1024 * 1536, 1536, (bf16*)(ws + WS_WIN) + (size_t)j * 1536 * 1024, 1024, kb * 64, n0, n0 < 512 ? n0 : n0 + 512, scr, lane); continue; } r -= 2 * I_IN;
            if (r < 2 * I_SQ) { const int j = r / I_SQ; r -= j * I_SQ; const int kb = r / 32, nb = r % 32;
                transpose_item(a.in[14] + (size_t)j * 1024 * 1024, 1024, (bf16*)(ws + WS_WOAB) + (size_t)j * 1024 * 1024, 1024, kb * 64, nb * 32, nb * 32, scr, lane); continue; } r -= 2 * I_SQ;
            if (r < 2 * I_QKV) { const int j = r / I_QKV; r -= j * I_QKV; const int kb = r / 96, nb = r % 96;
                transpose_item(a.in[15] + (size_t)j * 1024 * 3072, 3072, (bf16*)(ws + WS_WQKV) + (size_t)j * 3072 * 1024, 1024, kb * 64, nb * 32, nb * 32, scr, lane); continue; } r -= 2 * I_QKV;
            if (r < 2 * I_SQ) { const int j = r / I_SQ; r -= j * I_SQ; const int kb = r / 32, nb = r % 32;
                transpose_item(a.in[17] + (size_t)j * 1024 * 1024, 1024, (bf16*)(ws + WS_WONA) + (size_t)j * 1024 * 1024, 1024, kb * 64, nb * 32, nb * 32, scr, lane); continue; } r -= 2 * I_SQ;
            if (r < 4 * I_FI) { const int i = r / I_FI; r -= i * I_FI; const int kb = r / 176, nb = r % 176, n0 = nb * 32;
                const int jj = n0 < DFF ? n0 : n0 - DFF; const int drow0 = (jj >> 7) * 256 + (n0 < DFF ? 0 : 128) + (jj & 127);
                transpose_item(a.in[18] + (size_t)i * 1024 * NFI, NFI, (bf16*)(ws + WS_WFI) + (size_t)i * NFI * 1024, 1024, kb * 64, n0, drow0, scr, lane); continue; } r -= 4 * I_FI;
            { const int i = r / I_FO; r -= i * I_FO; const int kb = r / 32, nb = r % 32;
                transpose_item(a.in[19] + (size_t)i * DFF * 1024, 1024, (bf16*)(ws + WS_WFO) + (size_t)i * 1024 * DFF, DFF, kb * 64, nb * 32, nb * 32, scr, lane); }
        }
    }
    for (int e = bid * NT + tid; e < 2 * 4 * 128 * 128 / 2; e += G * NT) { const float2 v = *(const float2*)(a.in[10] + 2 * (size_t)e); ((unsigned*)(ws + WS_WS))[e] = pk2(v.x, v.y); }
    {
        float* prm = (float*)(ws + WS_PRM);
        for (int e = bid * NT + tid; e < PRM_TOTAL; e += G * NT) {
            float v;
            if (e < PRM_NFFN) v = a.in[6][e]; else if (e < PRM_LNV) v = a.in[7][e - PRM_NFFN]; else if (e < PRM_BS) v = a.in[9][e - PRM_LNV];
            else if (e < PRM_RPB) v = a.in[11][e - PRM_BS]; else if (e < PRM_NFIN) v = a.in[16][e - PRM_RPB] * LOG2E; else v = a.in[20][e - PRM_NFIN];
            prm[e] = v; }
        f32x4* xw = (f32x4*)(ws + WS_XW);
        for (int e = bid * NT + tid; e < MA * 256; e += G * NT) xw[e] = e < ML * 256 ? ((const f32x4*)a.in[0])[e] : ((const f32x4*)a.in[2])[e - ML * 256];
    }
    __syncthreads();
    for (int it = bid; it < 128; it += G) {
        const int j = it >> 6, g = (it >> 4) & 3, kb = it & 15, k0 = kb * 64;
        LAS float* wp = (LAS float*)lds; LAS float* wi = (LAS float*)(lds + 65536);
        const float* wpool = a.in[12] + (size_t)(j * 4 + g) * 16384;
#pragma unroll 4
        for (int i = 0; i < 32; ++i) wp[tid + 512 * i] = wpool[tid + 512 * i];
        const float* win = a.in[8] + (size_t)j * 1024 * 1536 + 1024 + g * 128;
#pragma unroll 4
        for (int i = 0; i < 16; ++i) { const int kk = (tid >> 7) + 4 * i, c = tid & 127; wi[kk * 129 + c] = win[(size_t)(k0 + kk) * 1536 + c]; }
        __syncthreads();
        const int kk = tid & 63, d0 = (tid >> 6) * 16;
        float acc[16];
#pragma unroll
        for (int i = 0; i < 16; ++i) acc[i] = 0.f;
        for (int c = 0; c < 128; ++c) { const float av = wi[kk * 129 + c];
#pragma unroll
            for (int i = 0; i < 16; ++i) acc[i] += av * wp[c * 128 + d0 + i]; }
        const float* ps = a.in[13] + j * 512 + g * 128 + d0;
        bf16* out = (bf16*)(ws + WS_WIN) + (size_t)j * 1536 * 1024 + (size_t)(512 + g * 128 + d0) * 1024 + k0 + kk;
#pragma unroll
        for (int i = 0; i < 16; ++i) out[(size_t)i * 1024] = (bf16)(pk2(acc[i] * ps[i], 0.f) & 0xffffu);
        __syncthreads();
    }
    {
        LAS float* sv = (LAS float*)lds;
        LAS float* red = (LAS float*)(lds + 20480);
        for (int e = tid; e < 5 * 1024; e += NT) { const float v = e < 4096 ? a.in[1][e] : a.in[3][e - 4096]; sv[e] = pg8::silu_f(v); }
        __syncthreads();
        for (int it = bid; it < 4 * 192; it += G) {
            const int layer = it / 192, n0 = (it % 192) * 32, col = tid & 31, ks = tid >> 5;
            const float* wm = a.in[4] + ((size_t)layer * 1024 + ks * 64) * 6144 + n0 + col;
            float acc[5] = {0.f, 0.f, 0.f, 0.f, 0.f};
#pragma unroll 8
            for (int k = 0; k < 64; ++k) { const float w = wm[(size_t)k * 6144];
#pragma unroll
                for (int c = 0; c < 5; ++c) acc[c] += sv[c * 1024 + ks * 64 + k] * w; }
#pragma unroll
            for (int c = 0; c < 5; ++c) red[(ks * 5 + c) * 32 + col] = acc[c];
            __syncthreads();
            if (tid < 160) { const int c = tid >> 5; float s = a.in[5][layer * 6144 + n0 + col];
#pragma unroll
                for (int q = 0; q < 16; ++q) s += red[(q * 5 + c) * 32 + col];
                ((float*)(ws + WS_MOD))[(size_t)(layer * 5 + c) * 6144 + n0 + col] = s; }
            __syncthreads();
        }
    }
}

__device__ __forceinline__ void rowpass(unsigned char* ws, int layer, int which, int Mrows, int lane, int gw, int NGW) {
    float* XW = (float*)(ws + WS_XW); bf16* HN = (bf16*)(ws + WS_HN);
    const float* gn = (const float*)(ws + WS_PRM) + (which ? PRM_NFFN : PRM_NMIX) + layer * 1024;
    const float* mod = (const float*)(ws + WS_MOD) + (size_t)layer * 5 * 6144 + (which ? 3 : 0) * 1024;
    f32x4 g4[4];
#pragma unroll
    for (int j = 0; j < 4; ++j) g4[j] = *(const f32x4*)(gn + 4 * lane + 256 * j);
    for (int m = gw; m < Mrows; m += NGW) {
        const float* src = XW + (size_t)m * D;
        const int cond = m < ML ? (m >> 12) : 4;
        const float* sh = mod + cond * 6144; const float* sc = sh + 1024;
        f32x4 v[4]; float s = 0.f;
#pragma unroll
        for (int j = 0; j < 4; ++j) { v[j] = *(const f32x4*)(src + 4 * lane + 256 * j); s += (v[j].x * v[j].x + v[j].y * v[j].y) + (v[j].z * v[j].z + v[j].w * v[j].w); }
        const float rstd = 1.0f / sqrtf(wave_sum(s, lane) * (1.f / D) + EPS);
#pragma unroll
        for (int j = 0; j < 4; ++j) {
            const f32x4 s4 = *(const f32x4*)(sc + 4 * lane + 256 * j), h4 = *(const f32x4*)(sh + 4 * lane + 256 * j);
            const f32x4 o = (v[j] * rstd) * g4[j] * (s4 + 1.0f) + h4;
            v2u w; w.x = pk2(o.x, o.y); w.y = pk2(o.z, o.w);
            *(v2u*)(HN + (size_t)m * D + 4 * lane + 256 * j) = w; }
    }
}

__device__ __forceinline__ void final_norm(unsigned char* ws, float* out, int lane, int gw, int NGW) {
    const float* XW = (const float*)(ws + WS_XW); const float* gn = (const float*)(ws + WS_PRM) + PRM_NFIN;
    f32x4 g4[4];
#pragma unroll
    for (int j = 0; j < 4; ++j) g4[j] = *(const f32x4*)(gn + 4 * lane + 256 * j);
    for (int m = gw; m < ML; m += NGW) {
        f32x4 v[4]; float s = 0.f;
#pragma unroll
        for (int j = 0; j < 4; ++j) { v[j] = *(const f32x4*)(XW + (size_t)m * D + 4 * lane + 256 * j); s += (v[j].x * v[j].x + v[j].y * v[j].y) + (v[j].z * v[j].z + v[j].w * v[j].w); }
        const float rstd = 1.0f / sqrtf(wave_sum(s, lane) * (1.f / D) + EPS);
#pragma unroll
        for (int j = 0; j < 4; ++j) *(f32x4*)(out + (size_t)m * D + 4 * lane + 256 * j) = (v[j] * rstd) * g4[j];
    }
}

__device__ __forceinline__ void mix_phase(unsigned char* ws, LAS unsigned char* lds, int j, int tid, int lane, int wave, int bid, int G) {
    const float* prm = (const float*)(ws + WS_PRM);
    const bf16* UQ = (const bf16*)(ws + WS_UQ); const bf16* GVT = (const bf16*)(ws + WS_GVT); bf16* Y = (bf16*)(ws + WS_Y);
    const float* stats = (const float*)(ws + WS_STATS); const bf16* WSb = (const bf16*)(ws + WS_WS);
    LAS float* st = (LAS float*)lds;
    const int li = lane & 15, gq = lane >> 4;
    for (int u = bid; u < 136 * 4; u += G) {
        const int chunk = u >> 2, g = u & 3, token0 = chunk * 128;
        int s0, L, seqbase;
        if (chunk < 128) { s0 = (chunk & 31) * 128; L = SEQ; seqbase = (chunk >> 5) * SEQ; } else { const int cc = chunk - 128; s0 = (cc & 1) * 128; L = CTXL; seqbase = ML + (cc >> 1) * CTXL; }
        __syncthreads();
        if (tid < 128) { const float* p = stats + (size_t)(token0 + tid) * 8; const f32x4 p0 = *(const f32x4*)p, p1 = *(const f32x4*)(p + 4);
            const float S = (p0.x + p0.z) + (p1.x + p1.z), Q = (p0.y + p0.w) + (p1.y + p1.w);
            const float mean = S * (1.f / 512.f); const float var = fmaxf(Q * (1.f / 512.f) - mean * mean, 0.f);
            st[2 * tid] = mean; st[2 * tid + 1] = 1.0f / sqrtf(var + EPS); }
        __syncthreads();
        {
            const int c = 16 * wave + li;
            const float lnv = prm[PRM_LNV + j * 512 + g * 128 + c];
            f32x4 acc[8];
#pragma unroll
            for (int ib = 0; ib < 8; ++ib) acc[ib] = (f32x4){0.f, 0.f, 0.f, 0.f};
#pragma unroll
            for (int ks = 0; ks < 4; ++ks) {
                const v4u raw = *(const v4u*)(GVT + (size_t)(g * 128 + c) * MA + token0 + 32 * ks + 8 * gq);
                const LAS f32x4* sp = (const LAS f32x4*)(st + 2 * (32 * ks + 8 * gq));
                const f32x4 m0 = sp[0], m1 = sp[1], m2 = sp[2], m3 = sp[3];
                v4u an;
                an.x = pk2((bf2f(raw.x & 0xffffu) - m0.x) * m0.y * lnv, (bf2f(raw.x >> 16) - m0.z) * m0.w * lnv);
                an.y = pk2((bf2f(raw.y & 0xffffu) - m1.x) * m1.y * lnv, (bf2f(raw.y >> 16) - m1.z) * m1.w * lnv);
                an.z = pk2((bf2f(raw.z & 0xffffu) - m2.x) * m2.y * lnv, (bf2f(raw.z >> 16) - m2.z) * m2.w * lnv);
                an.w = pk2((bf2f(raw.w & 0xffffu) - m3.x) * m3.y * lnv, (bf2f(raw.w >> 16) - m3.z) * m3.w * lnv);
                const bf16x8 af = __builtin_bit_cast(bf16x8, an);
#pragma unroll
                for (int ib = 0; ib < 8; ++ib) {
                    const bf16x8 bfr = *(const bf16x8*)(WSb + ((size_t)((j * 4 + g) * 128 + 16 * ib + li)) * 128 + 32 * ks + 8 * gq);
                    acc[ib] = __builtin_amdgcn_mfma_f32_16x16x32_bf16(af, bfr, acc[ib], 0, 0, 0); }
            }
            const int cc = g * 128 + 16 * wave + 4 * gq;
#pragma unroll
            for (int ib = 0; ib < 8; ++ib) {
                const int tok = token0 + 16 * ib + li;
                const float bs = prm[PRM_BS + (j * 4 + g) * 128 + 16 * ib + li];
                const v2u uu = *(const v2u*)(UQ + (size_t)tok * 1024 + cc);
                v2u o; o.x = pk2(bf2f(uu.x & 0xffffu) * (acc[ib][0] + bs), bf2f(uu.x >> 16) * (acc[ib][1] + bs));
                o.y = pk2(bf2f(uu.y & 0xffffu) * (acc[ib][2] + bs), bf2f(uu.y >> 16) * (acc[ib][3] + bs));
                *(v2u*)(Y + (size_t)tok * 1024 + cc) = o; }
        }
        {
            const int c8 = tid & 15, rg = tid >> 4, hw = 1 << g;
            const int t0 = s0 + 4 * rg;
            const int rlo = max(t0 - hw, 0), rhi = min(t0 + 3 + hw, L);
            float sum[4][8], self[4][8];
#pragma unroll
            for (int tt = 0; tt < 4; ++tt)
#pragma unroll
                for (int e = 0; e < 8; ++e) { sum[tt][e] = 0.f; self[tt][e] = 0.f; }
            const bf16* qb = UQ + (size_t)seqbase * 1024 + 512 + g * 128 + c8 * 8;
            for (int r = rlo; r < rhi; ++r) {
                const v4u raw = *(const v4u*)(qb + (size_t)r * 1024);
                float f[8]; f[0] = bf2f(raw.x & 0xffffu); f[1] = bf2f(raw.x >> 16); f[2] = bf2f(raw.y & 0xffffu); f[3] = bf2f(raw.y >> 16);
                f[4] = bf2f(raw.z & 0xffffu); f[5] = bf2f(raw.z >> 16); f[6] = bf2f(raw.w & 0xffffu); f[7] = bf2f(raw.w >> 16);
#pragma unroll
                for (int tt = 0; tt < 4; ++tt) { const int t = t0 + tt; const bool in = (r >= t - hw) && (r < t + hw); const bool me = (r == t);
#pragma unroll
                    for (int e = 0; e < 8; ++e) { sum[tt][e] += in ? f[e] : 0.f; self[tt][e] = me ? f[e] : self[tt][e]; } }
            }
#pragma unroll
            for (int tt = 0; tt < 4; ++tt) { const int t = t0 + tt; const int lo = max(t - hw, 0), hi = min(t + hw, L); const float inv = 1.0f / (float)(hi - lo);
                v4u o; o.x = pk2(sum[tt][0] * inv - self[tt][0], sum[tt][1] * inv - self[tt][1]); o.y = pk2(sum[tt][2] * inv - self[tt][2], sum[tt][3] * inv - self[tt][3]);
                o.z = pk2(sum[tt][4] * inv - self[tt][4], sum[tt][5] * inv - self[tt][5]); o.w = pk2(sum[tt][6] * inv - self[tt][6], sum[tt][7] * inv - self[tt][7]);
                *(v4u*)(Y + (size_t)(seqbase + t) * 1024 + 512 + g * 128 + c8 * 8) = o; }
        }
    }
}

template <bool CTXQ>
__device__ __forceinline__ void attn_wave(const bf16* QK, const bf16* VT, bf16* O, const LAS float* rpbL, int b, int h, int r, int jg, int qtok0, int lane) {
    const int li = lane & 15, gq = lane >> 4;
    constexpr int NCH = CTXQ ? 8 : 16, NNB = CTXQ ? 0 : 8;
    bf16x8 qf[2];
    { const bf16* qp = QK + (size_t)(qtok0 + li) * 2048 + h * 64 + 8 * gq; qf[0] = *(const bf16x8*)qp; qf[1] = *(const bf16x8*)(qp + 32); }
    const int kwin0 = jg == 0 ? 0 : (jg == 1 ? 8 : (jg == 2 ? 24 : 32));
    const int rs = min(max(r - 4, 0), 56);
    const int kofs = (li >> 2) * 8 + (li & 3);
    const int nbbase = b * SEQ + rs * 64 + kwin0, cxbase = ML + b * CTXL;
    f32x4 s[NCH][2];
#pragma unroll
    for (int ch = 0; ch < NCH; ++ch) {
        const int base = ch < NNB ? nbbase + ch * 64 : cxbase + 32 * (ch - NNB);
#pragma unroll
        for (int t = 0; t < 2; ++t) {
            const bf16* kp = QK + (size_t)(base + kofs + 4 * t) * 2048 + 1024 + h * 64 + 8 * gq;
            const bf16x8 k0 = *(const bf16x8*)kp, k1 = *(const bf16x8*)(kp + 32);
            f32x4 c = (f32x4){0.f, 0.f, 0.f, 0.f};
            c = __builtin_amdgcn_mfma_f32_16x16x32_bf16(k0, qf[0], c, 0, 0, 0);
            c = __builtin_amdgcn_mfma_f32_16x16x32_bf16(k1, qf[1], c, 0, 0, 0);
            s[ch][t] = c; }
    }
    if (!CTXQ) {
        const int cq = 16 * jg + li, cs = min(max(cq - 8, 0), 48);
#pragma unroll
        for (int ch = 0; ch < NNB; ++ch) { const int dr = rs + ch - r + 7;
#pragma unroll
            for (int t = 0; t < 2; ++t)
#pragma unroll
                for (int e = 0; e < 4; ++e) { const int kc = kwin0 + 8 * gq + 4 * t + e; const bool valid = (kc >= cs) && (kc < cs + 16);
                    const int dc = min(max(kc - cq + 15, 0), 30); const float bias = rpbL[dr * 31 + dc];
                    s[ch][t][e] = valid ? s[ch][t][e] + bias : -1e30f; } }
    }
    float mx = -1e30f;
#pragma unroll
    for (int ch = 0; ch < NCH; ++ch)
#pragma unroll
        for (int t = 0; t < 2; ++t)
#pragma unroll
            for (int e = 0; e < 4; ++e) mx = fmaxf(mx, s[ch][t][e]);
    mx = fmaxf(mx, pg8::xshfl<16>(mx)); mx = fmaxf(mx, pg8::xshfl32(mx, lane));
    float lsum = 0.f; bf16x8 pf[NCH];
#pragma unroll
    for (int ch = 0; ch < NCH; ++ch) { float p[8];
#pragma unroll
        for (int t = 0; t < 2; ++t)
#pragma unroll
            for (int e = 0; e < 4; ++e) { p[4 * t + e] = __builtin_amdgcn_exp2f(s[ch][t][e] - mx); lsum += p[4 * t + e]; }
        v4u w; w.x = pk2(p[0], p[1]); w.y = pk2(p[2], p[3]); w.z = pk2(p[4], p[5]); w.w = pk2(p[6], p[7]);
        pf[ch] = __builtin_bit_cast(bf16x8, w); }
    lsum += pg8::xshfl<16>(lsum); lsum += pg8::xshfl32(lsum, lane);
    const float inv = 1.0f / lsum;
#pragma unroll
    for (int db = 0; db < 4; ++db) {
        f32x4 o = (f32x4){0.f, 0.f, 0.f, 0.f};
        const bf16* vrow = VT + (size_t)(h * 64 + 16 * db + li) * MA + 8 * gq;
#pragma unroll
        for (int ch = 0; ch < NCH; ++ch) { const int base = ch < NNB ? nbbase + ch * 64 : cxbase + 32 * (ch - NNB);
            const bf16x8 vf = *(const bf16x8*)(vrow + base);
            o = __builtin_amdgcn_mfma_f32_16x16x32_bf16(vf, pf[ch], o, 0, 0, 0); }
        v2u w; w.x = pk2(o[0] * inv, o[1] * inv); w.y = pk2(o[2] * inv, o[3] * inv);
        *(v2u*)(O + (size_t)(qtok0 + li) * 1024 + h * 64 + 16 * db + 4 * gq) = w; }
}

__device__ __forceinline__ void attn_phase(unsigned char* ws, LAS unsigned char* lds, int j, bool ctxq, int tid, int lane, int wave, int bid, int G) {
    const bf16* QK = (const bf16*)(ws + WS_QK); const bf16* VT = (const bf16*)(ws + WS_VT); bf16* O = (bf16*)(ws + WS_O);
    LAS float* rpbL = (LAS float*)lds;
    for (int u = bid; u < 2048; u += G) {
        const int x = u & 7, within = u >> 3, bh = x * 8 + (within >> 5), rp = within & 31, b = bh >> 4, h = bh & 15;
        __syncthreads();
        if (tid < 465) rpbL[tid] = ((const float*)(ws + WS_PRM))[PRM_RPB + (j * 16 + h) * 465 + tid];
        __syncthreads();
        const int r = 2 * rp + (wave >> 2), jg = wave & 3;
        attn_wave<false>(QK, VT, O, rpbL, b, h, r, jg, b * SEQ + r * 64 + 16 * jg, lane);
    }
    if (ctxq) for (int u = bid; u < 128; u += G) {
        const int bh = u >> 1, part = u & 1, b = bh >> 4, h = bh & 15;
        attn_wave<true>(QK, VT, O, rpbL, b, h, 0, 0, ML + b * CTXL + 128 * part + 16 * wave, lane);
    }
}

#define XB_TMO      128
#define XB_XCNT(j)  (256  + 64 * (j))
#define XB_XSUB(j)  (1280 + 64 * (j))
#define XB_XGEN(j)  (2304 + 64 * (j))
#define XB_TOP      3328
#define XB_TOPGEN   3392
#define XCD_BAR_WORDS 3456
#define XB_SPIN_CAP (1u << 18)

__device__ __forceinline__ unsigned xb_ld(unsigned* p)              { return __hip_atomic_load(p, __ATOMIC_RELAXED, __HIP_MEMORY_SCOPE_AGENT); }
__device__ __forceinline__ unsigned xb_add(unsigned* p, unsigned v) { return __hip_atomic_fetch_add(p, v, __ATOMIC_RELAXED, __HIP_MEMORY_SCOPE_AGENT); }
__device__ __forceinline__ unsigned xb_xcc_id() { return (unsigned)__builtin_amdgcn_s_getreg((3 << 11) | 20) & 0xFu; }
#define XB_SPIN(cond, bar) do { unsigned _sp = 0; while (cond) { __builtin_amdgcn_s_sleep(1); \
    if ((++_sp & 255u) == 0u) { if (xb_ld(&(bar)[XB_TMO])) break; if (_sp > XB_SPIN_CAP) { atomicAdd(&(bar)[XB_TMO], 1u); break; } } } } while (0)

struct XcdBarrier {
    unsigned* bar; unsigned x;
    volatile LAS unsigned* st;
};

__device__ __forceinline__ XcdBarrier xcd_barrier_post(unsigned* bar, volatile LAS unsigned* st) {
    XcdBarrier b; b.bar = bar; b.x = xb_xcc_id(); b.st = st;
    if (threadIdx.x == 0) (void)xb_add(&bar[XB_XCNT(b.x)], 1u);
    return b;
}
__device__ __forceinline__ void xcd_barrier_complete(unsigned* bar, unsigned x, unsigned& nloc, unsigned& nx) {
    const unsigned G = gridDim.x * gridDim.y * gridDim.z;
    unsigned sum, cnt, mine, sp = 0u;
    for (;;) {
        sum = 0u; cnt = 0u; mine = 0u;
#pragma unroll
        for (unsigned j = 0; j < 16; ++j) { const unsigned c = xb_ld(&bar[XB_XCNT(j)]); sum += c; cnt += (c > 0u) ? 1u : 0u; mine = (j == x) ? c : mine; }
        if (sum == G) break;
        __builtin_amdgcn_s_sleep(1);
        if ((++sp & 255u) == 0u) { if (xb_ld(&bar[XB_TMO])) break; if (sp > XB_SPIN_CAP) { atomicAdd(&bar[XB_TMO], 1u); break; } }
    }
    nloc = mine > 0u ? mine : 1u; nx = cnt > 0u ? cnt : 1u;
}

__device__ __forceinline__ void xcd_barrier(const XcdBarrier& b) {
    asm volatile("s_waitcnt vmcnt(0)" ::: "memory");
    __syncthreads();
    if (threadIdx.x == 0) {
        unsigned* bar = b.bar;
        __builtin_amdgcn_s_waitcnt(0);
        unsigned nloc = b.st[0], nx = b.st[1];
        if (nloc == 0u) { xcd_barrier_complete(bar, b.x, nloc, nx); b.st[0] = nloc; b.st[1] = nx; }
        const unsigned old = xb_add(&bar[XB_XSUB(b.x)], 1u);
        const unsigned gen = old / nloc;
        if (old + 1u == (gen + 1u) * nloc) {
            __builtin_amdgcn_fence(__ATOMIC_RELEASE, "agent");
            asm volatile("s_waitcnt vmcnt(0)" ::: "memory");
            const unsigned og = xb_add(&bar[XB_TOP], 1u);
            const unsigned tg = og / nx;
            if (og + 1u == (tg + 1u) * nx) xb_add(&bar[XB_TOPGEN], 1u);
            else XB_SPIN(xb_ld(&bar[XB_TOPGEN]) == tg, bar);
            __builtin_amdgcn_fence(__ATOMIC_ACQUIRE, "agent");
            xb_add(&bar[XB_XGEN(b.x)], 1u);
            asm volatile("s_waitcnt vmcnt(0)" ::: "memory");
        } else {
            XB_SPIN(xb_ld(&bar[XB_XGEN(b.x)]) == gen, bar);
            __builtin_amdgcn_fence(__ATOMIC_ACQUIRE, "agent");
            asm volatile("s_waitcnt vmcnt(0)" ::: "memory");
        }
    }
    __syncthreads();
}

constexpr size_t WS_BAR = 0;
__global__ void __launch_bounds__(NT, 2) mega(Args a) {
    extern __shared__ __attribute__((aligned(16))) unsigned char lds_raw[];
    LAS unsigned char* lds = (LAS unsigned char*)lds_raw;
    cg::grid_group grid = cg::this_grid();
#ifndef PROBE_SYNC
#define PROBE_SYNC 0
#endif
#ifndef PROBE_ATTN
#define PROBE_ATTN 0
#endif
#ifndef PROBE_MIX
#define PROBE_MIX 0
#endif
#ifndef PROBE_ROW
#define PROBE_ROW 0
#endif
#ifndef PROBE_PRO
#define PROBE_PRO 0
#endif
    volatile LAS unsigned* bst = (volatile LAS unsigned*)(lds + 131072);
    if (threadIdx.x < 2) bst[threadIdx.x] = 0u;
    if (blockIdx.x == 0) for (int t = threadIdx.x; t < XCD_BAR_WORDS; t += NT) __hip_atomic_store((unsigned*)(a.ws + WS_BAR) + t, 0u, __ATOMIC_RELAXED, __HIP_MEMORY_SCOPE_AGENT);
    XcdBarrier xbar;
#define GSYNC() do { xcd_barrier(xbar); if (PROBE_SYNC) xcd_barrier(xbar); } while (0)
    const int G = gridDim.x, bid = blockIdx.x;
    const int vcu = (G % 8 == 0) ? (bid % 8) * (G / 8) + bid / 8 : bid;
    const int NGW = G * NWAVES;
#define TIDS() int tid = threadIdx.x; asm volatile("" : "+v"(tid)); const int lane = tid & 63, wave = __builtin_amdgcn_readfirstlane(tid >> 6), gw = vcu * NWAVES + wave; (void)lane; (void)gw
    unsigned char* ws = a.ws; float* out = a.out;
    bf16* HN = (bf16*)(ws + WS_HN);
    const float* MOD = (const float*)(ws + WS_MOD);

    { TIDS(); prologue(a, lds, tid, lane, wave, bid, G, gw, NGW); if (PROBE_PRO) { __syncthreads(); prologue(a, lds, tid, lane, wave, bid, G, gw, NGW); } }
    grid.sync();
    xbar = xcd_barrier_post((unsigned*)(a.ws + WS_BAR), bst);
#pragma unroll 1
    for (int i = 0; i < 4; ++i) {
        const bool odd = (i & 1) != 0, last = (i == 3); const int j = i >> 1; const int Mact = last ? ML : MA;
        { TIDS(); rowpass(ws, i, 0, MA, lane, gw, NGW); if (PROBE_ROW) rowpass(ws, i, 0, MA, lane, gw, NGW); }
        GSYNC();
        if (odd) {
            { pg8::Gemm g{HN, (const bf16*)(ws + WS_WQKV) + (size_t)j * 3072 * 1024, MA, 2048, 1024}; pg8::StaticOrder S; S.init(MA, 2048, G, bid);
              pg8::EpiStoreBf16 E{(bf16*)(ws + WS_QK), 2048, 0, 4, 0.125f * LOG2E};
              pg8::gemm_phase<pg8::EpiStoreBf16, pg8::StaticOrder, true, true>(lds, g, S, E); }
            { pg8::Gemm g{(const bf16*)(ws + WS_WQKV) + (size_t)j * 3072 * 1024 + (size_t)2048 * 1024, HN, 1024, MA, 1024}; pg8::StaticOrder S; S.init(1024, MA, G, bid);
              pg8::EpiStoreBf16 E{(bf16*)(ws + WS_VT), MA, 0, 0, 1.f};
              pg8::gemm_phase<pg8::EpiStoreBf16, pg8::StaticOrder, true, true>(lds, g, S, E); }
        } else {
            { pg8::Gemm g{HN, (const bf16*)(ws + WS_WIN) + (size_t)j * 1536 * 1024, MA, 1024, 1024}; pg8::StaticOrder S; S.init(MA, 1024, G, bid);
              pg8::EpiStoreBf16 E{(bf16*)(ws + WS_UQ), 1024, 2, 0, 1.f};
              pg8::gemm_phase<pg8::EpiStoreBf16, pg8::StaticOrder, true, true>(lds, g, S, E); }
            { pg8::Gemm g{(const bf16*)(ws + WS_WIN) + (size_t)j * 1536 * 1024 + (size_t)1024 * 1024, HN, 512, MA, 1024}; pg8::StaticOrder S; S.init(512, MA, G, bid);
              pg8::EpiGVt E{(bf16*)(ws + WS_GVT), MA, (float*)(ws + WS_STATS)};
              pg8::gemm_phase<pg8::EpiGVt, pg8::StaticOrder, true, true>(lds, g, S, E); }
        }
        GSYNC();
        if (odd) { TIDS(); attn_phase(ws, lds, j, !last, tid, lane, wave, bid, G); if (PROBE_ATTN) { __syncthreads(); attn_phase(ws, lds, j, !last, tid, lane, wave, bid, G); } }
        else { TIDS(); mix_phase(ws, lds, j, tid, lane, wave, bid, G); if (PROBE_MIX) { __syncthreads(); mix_phase(ws, lds, j, tid, lane, wave, bid, G); } }
        GSYNC();
        { pg8::Gemm g{odd ? (const bf16*)(ws + WS_O) : (const bf16*)(ws + WS_Y), odd ? (const bf16*)(ws + WS_WONA) + (size_t)j * 1024 * 1024 : (const bf16*)(ws + WS_WOAB) + (size_t)j * 1024 * 1024, Mact, 1024, 1024};
          pg8::StaticOrder S; S.init(Mact, 1024, G, bid);
          pg8::EpiResGate E{(float*)(ws + WS_XW), MOD + (size_t)i * 5 * 6144 + 2 * 1024};
          pg8::gemm_phase<pg8::EpiResGate, pg8::StaticOrder, true, true>(lds, g, S, E); }
        GSYNC();
        { TIDS(); rowpass(ws, i, 1, Mact, lane, gw, NGW); if (PROBE_ROW) rowpass(ws, i, 1, Mact, lane, gw, NGW); }
        GSYNC();
        { pg8::Gemm g{HN, (const bf16*)(ws + WS_WFI) + (size_t)i * NFI * 1024, Mact, NFI, 1024}; pg8::StaticOrder S; S.init(Mact, NFI, G, bid);
          pg8::EpiSwiGLU E{(bf16*)(ws + WS_H2), DFF};
          pg8::gemm_phase<pg8::EpiSwiGLU, pg8::StaticOrder, true, true>(lds, g, S, E); }
        GSYNC();
        { pg8::Gemm g{(const bf16*)(ws + WS_H2), (const bf16*)(ws + WS_WFO) + (size_t)i * 1024 * DFF, Mact, 1024, DFF}; pg8::StaticOrder S; S.init(Mact, 1024, G, bid);
          pg8::EpiResGate E{(float*)(ws + WS_XW), MOD + (size_t)i * 5 * 6144 + 5 * 1024};
          pg8::gemm_phase<pg8::EpiResGate, pg8::StaticOrder, true, true>(lds, g, S, E); }
        GSYNC();
    }
    { TIDS(); final_norm(ws, out, lane, gw, NGW); }
}

extern "C" void kernel_launch(void* const* d_in, const int* in_sizes, int n_in, void* d_out, int out_size, void* d_ws, size_t ws_size, hipStream_t stream) {
    static int grid = 0;
    if (grid == 0) {
        if (n_in != 21 || ws_size < WS_END) { fprintf(stderr, "kernel_launch: expected 21 inputs and >= %zu bytes of workspace (got %d, %zu)\n", (size_t)WS_END, n_in, ws_size); grid = -1; return; }
        int dev = 0, cus = 0, per_cu = 0;
        (void)hipGetDevice(&dev); (void)hipDeviceGetAttribute(&cus, hipDeviceAttributeMultiprocessorCount, dev);
        if (hipFuncSetAttribute((const void*)mega, hipFuncAttributeMaxDynamicSharedMemorySize, LDS_BYTES) != hipSuccess) fprintf(stderr, "kernel_launch: hipFuncSetAttribute failed\n");
        if (hipOccupancyMaxActiveBlocksPerMultiprocessor(&per_cu, (const void*)mega, NT, LDS_BYTES) != hipSuccess || per_cu < 1) { fprintf(stderr, "kernel_launch: occupancy query says %d\n", per_cu); per_cu = 1; }
        (void)hipGetLastError();
        grid = cus > 0 ? cus : 256;
    }
    if (grid < 0) return;
    Args a{};
    for (int i = 0; i < 21; ++i) a.in[i] = (const float*)d_in[i];
    a.out = (float*)d_out; a.ws = (unsigned char*)d_ws;
    void* args[] = {&a};
    hipError_t e = hipLaunchCooperativeKernel((const void*)mega, dim3(grid), dim3(NT), args, LDS_BYTES, stream);
    if (e != hipSuccess) fprintf(stderr, "kernel_launch: cooperative launch failed: %s (grid %d)\n", hipGetErrorString(e), grid);
}
```

```cpp
#include <hip/hip_runtime.h>
#include <hip/hip_cooperative_groups.h>
#include <cstdio>
#include <cstdint>
namespace cg = cooperative_groups;
namespace pg8 {
#define PG8_LAS __attribute__((address_space(3)))
typedef unsigned short bf16_t;
typedef short bf16x8 __attribute__((ext_vector_type(8)));
typedef float f32x4 __attribute__((ext_vector_type(4)));
typedef unsigned u32x4 __attribute__((ext_vector_type(4)));
constexpr int BM = 256, BK = 64, HALF = 128, HTB = HALF * BK * 2  , STAGE_BYTES = 8 * HTB, NXCD = 8, WGM = 8;

__host__ __device__ __forceinline__ int lds_byte(int r, int c) { const int st = (r >> 4) * 2 + (c >> 5), rr = r & 15, cc = c & 31, ob = rr * 64 + cc * 2; return st * 1024 + (ob ^ (((ob >> 9) & 1) << 5)); }
__host__ __device__ __forceinline__ void stage_rc(int b, int& R, int& C) { const int st = b / 1024, sb = b % 1024, swz = sb ^ (((sb >> 9) & 1) << 5); R = (st >> 1) * 16 + swz / 64; C = (st & 1) * 32 + (swz % 64) / 2; }
__host__ __device__ __forceinline__ int perm32(int rho) { const int n = rho >> 4, i = rho & 15; return 8 * (i >> 2) + 4 * n + (i & 3); }

struct Unit { int pm, pn; };
struct Gemm { const bf16_t* A; const bf16_t* Bt; int M, N, K; };

struct StaticOrder {
    int nM, nN, nwg, G, c;
    __host__ __device__ void init(int M, int N, int G_, int c_) { nM = M / BM; nN = N / BM; nwg = nM * nN; G = G_; c = c_; }
    __host__ __device__ bool next(int i, Unit& u) const {
        const long L = (long)i * G + c; if (L >= nwg) return false;
        int wgid = (int)L; { const int q = nwg / NXCD, r = nwg % NXCD, xcd = wgid % NXCD, off = wgid / NXCD; wgid = (xcd < r ? xcd * (q + 1) : r * (q + 1) + (xcd - r) * q) + off; }
        const int nig = WGM * nN, gid = wgid / nig, fm = gid * WGM, gsz = (nM - fm) < WGM ? (nM - fm) : WGM;
        u.pm = fm + ((wgid % nig) % gsz); u.pn = (wgid % nig) / gsz; return true;
    }
    __device__ __forceinline__ void a_ready(const Unit&) const {}
    __device__ __forceinline__ void done(const Unit&) const {}
};

__device__ __forceinline__ unsigned cvt_pk_bf16(float lo, float hi) { unsigned r; asm volatile("v_cvt_pk_bf16_f32 %0, %1, %2" : "=v"(r) : "v"(lo), "v"(hi)); return r; }
typedef float f32x2 __attribute__((ext_vector_type(2)));
__device__ __forceinline__ float gelu_tanh_f(float x) {
    const float y = x * (0.7978845608f + 0.0356774081f * x * x);
    const float e = __builtin_amdgcn_exp2f(-2.885390082f * y);
    return x * __builtin_amdgcn_rcpf(1.0f + e);
}
template <int O> __device__ __forceinline__ float xshfl(float v) { static_assert(O < 32, "xshfl<O>: O < 32"); return __uint_as_float((unsigned)__builtin_amdgcn_ds_swizzle((int)__float_as_uint(v), (O << 10) | 0x1f)); }
__device__ __forceinline__ float xshfl32(float v, int lane) { return __uint_as_float((unsigned)__builtin_amdgcn_ds_bpermute((lane ^ 32) << 2, (int)__float_as_uint(v))); }
__device__ __forceinline__ float silu_f(float x) { return x * __builtin_amdgcn_rcpf(1.0f + __builtin_amdgcn_exp2f(-1.4426950409f * x)); }

struct EpiStoreBf16 {
    static constexpr bool PERM = true, AFTER_DRAIN = false;
    bf16_t* O; int ldc; int gelu_pn_lt; int scale_pn_lt; float scale0;
    __device__ __forceinline__ void operator()(const f32x4 (&acc)[2][2][4][2], const Unit& u, int wr, int wc, int fr, int fq) const {
        const int row0 = u.pm * BM + wr * 64 + fr; const int col0 = u.pn * BM + wc * 32 + 8 * fq;
        const bool act = u.pn < gelu_pn_lt; const float sc = (u.pn < scale_pn_lt) ? scale0 : 1.f;
#pragma unroll
        for (int ai = 0; ai < 2; ++ai)
#pragma unroll
            for (int m = 0; m < 4; ++m) { bf16_t* rowp = O + (size_t)(row0 + ai * HALF + m * 16) * ldc + col0;
#pragma unroll
                for (int bj = 0; bj < 2; ++bj) { f32x4 v0 = acc[ai][bj][m][0], v1 = acc[ai][bj][m][1];
                    if (act) {
#pragma unroll
                        for (int e = 0; e < 4; ++e) { v0[e] = gelu_tanh_f(v0[e]); v1[e] = gelu_tanh_f(v1[e]); } }
                    v0 = v0 * sc; v1 = v1 * sc; u32x4 w; w.x = cvt_pk_bf16(v0[0], v0[1]); w.y = cvt_pk_bf16(v0[2], v0[3]); w.z = cvt_pk_bf16(v1[0], v1[1]); w.w = cvt_pk_bf16(v1[2], v1[3]);
                    *(u32x4*)(rowp + bj * HALF) = w; } }
    }
};

struct EpiGVt {
    static constexpr bool PERM = true, AFTER_DRAIN = false;
    bf16_t* O; int ldc; float* stats;
    __device__ __forceinline__ void operator()(const f32x4 (&acc)[2][2][4][2], const Unit& u, int wr, int wc, int fr, int fq) const {
        const int row0 = u.pm * BM + wr * 64 + fr; const int col0 = u.pn * BM + wc * 32 + 8 * fq;
        const int slot = u.pm * 2 + wr;
#pragma unroll
        for (int bj = 0; bj < 2; ++bj) {
            float s[2][4], q[2][4];
#pragma unroll
            for (int n = 0; n < 2; ++n)
#pragma unroll
                for (int e = 0; e < 4; ++e) { s[n][e] = 0.f; q[n][e] = 0.f; }
#pragma unroll
            for (int ai = 0; ai < 2; ++ai)
#pragma unroll
                for (int m = 0; m < 4; ++m) { bf16_t* rowp = O + (size_t)(row0 + ai * HALF + m * 16) * ldc + col0;
                    f32x4 v0 = acc[ai][bj][m][0], v1 = acc[ai][bj][m][1];
#pragma unroll
                    for (int e = 0; e < 4; ++e) { v0[e] = gelu_tanh_f(v0[e]); v1[e] = gelu_tanh_f(v1[e]);
                        s[0][e] += v0[e]; q[0][e] += v0[e] * v0[e]; s[1][e] += v1[e]; q[1][e] += v1[e] * v1[e]; }
                    u32x4 w; w.x = cvt_pk_bf16(v0[0], v0[1]); w.y = cvt_pk_bf16(v0[2], v0[3]); w.z = cvt_pk_bf16(v1[0], v1[1]); w.w = cvt_pk_bf16(v1[2], v1[3]);
                    *(u32x4*)(rowp + bj * HALF) = w; }
#pragma unroll
            for (int n = 0; n < 2; ++n)
#pragma unroll
                for (int e = 0; e < 4; ++e) { float a = s[n][e], b = q[n][e];
                    a += xshfl<1>(a); b += xshfl<1>(b); a += xshfl<2>(a); b += xshfl<2>(b); a += xshfl<4>(a); b += xshfl<4>(b); a += xshfl<8>(a); b += xshfl<8>(b);
                    if (fr == 0) { float* p = stats + ((size_t)(col0 + bj * HALF + 4 * n + e) * 4 + slot) * 2; p[0] = a; p[1] = b; } }
            asm volatile("" ::: "memory");
        }
    }
};

struct EpiResGate {
    static constexpr bool PERM = false, AFTER_DRAIN = false;
    float* X; const float* gate_base;
    __device__ __forceinline__ void operator()(const f32x4 (&acc)[2][2][4][2], const Unit& u, int wr, int wc, int fr, int fq) const {
        const int cond = u.pm < 64 ? (u.pm >> 4) : 4; const float* gate = gate_base + cond * 6144;
        const int col0 = u.pn * BM + wc * 32 + 4 * fq;
        f32x4 gv[2][2];
#pragma unroll
        for (int bj = 0; bj < 2; ++bj)
#pragma unroll
            for (int n = 0; n < 2; ++n) gv[bj][n] = *(const f32x4*)(gate + col0 + bj * HALF + n * 16);
#pragma unroll
        for (int ai = 0; ai < 2; ++ai)
#pragma unroll
            for (int m = 0; m < 4; ++m) { float* rowp = X + (size_t)(u.pm * BM + ai * HALF + wr * 64 + m * 16 + fr) * 1024 + col0;
#pragma unroll
                for (int bj = 0; bj < 2; ++bj)
#pragma unroll
                    for (int n = 0; n < 2; ++n) { f32x4* p = (f32x4*)(rowp + bj * HALF + n * 16); *p = *p + gv[bj][n] * acc[ai][bj][m][n]; } }
    }
};

struct EpiSwiGLU {
    static constexpr bool PERM = true, AFTER_DRAIN = false;
    bf16_t* O; int ldc;
    __device__ __forceinline__ void operator()(const f32x4 (&acc)[2][2][4][2], const Unit& u, int wr, int wc, int fr, int fq) const {
        const int row0 = u.pm * BM + wr * 64 + fr; const int col0 = u.pn * HALF + wc * 32 + 8 * fq;
#pragma unroll
        for (int ai = 0; ai < 2; ++ai)
#pragma unroll
            for (int m = 0; m < 4; ++m) { bf16_t* rowp = O + (size_t)(row0 + ai * HALF + m * 16) * ldc + col0;
                f32x4 v0, v1;
#pragma unroll
                for (int e = 0; e < 4; ++e) { v0[e] = silu_f(acc[ai][0][m][0][e]) * acc[ai][1][m][0][e]; v1[e] = silu_f(acc[ai][0][m][1][e]) * acc[ai][1][m][1][e]; }
                u32x4 w; w.x = cvt_pk_bf16(v0[0], v0[1]); w.y = cvt_pk_bf16(v0[2], v0[3]); w.z = cvt_pk_bf16(v1[0], v1[1]); w.w = cvt_pk_bf16(v1[2], v1[3]);
                *(u32x4*)rowp = w; }
    }
};

template <class Epi, class Sched, bool ALIGN_EPI = false, bool SP2 = false>
__device__ __forceinline__ void gemm_phase(PG8_LAS unsigned char* lds, const Gemm g, const Sched& S, const Epi& E) {
    int tid_l = threadIdx.x; asm volatile("" : "+v"(tid_l));
    const int tid = tid_l, wid = __builtin_amdgcn_readfirstlane(tid >> 6), lane = tid & 63, wr = wid >> 2, wc = wid & 3, fr = lane & 15, fq = lane >> 4;
    const int K = g.K, nt = K / BK;
    unsigned voffA[2], voffB[2];
#pragma unroll
    for (int i = 0; i < 2; ++i) { int R, C; stage_rc(tid * 16 + i * 8192, R, C); const int Rb = Epi::PERM ? ((R & ~31) + perm32(R & 31)) : R;
        voffA[i] = (unsigned)(R * K + C) * 2u; voffB[i] = (unsigned)(Rb * K + C) * 2u; }
    const size_t kstep = (size_t)(BK * 2);
    const size_t hstep = (size_t)HALF * K * 2;
    const size_t tstep = 2 * hstep;
    const unsigned ldsw = (unsigned)wid * 1024u;
    const int aoff = lds_byte(wr * 64 + fr, fq * 8), boff = lds_byte(wc * 32 + fr, fq * 8);
#define PG8_SA(b, h) (((b) * 2 + (h)) * HTB)
#define PG8_SB(b, h) ((4 + (b) * 2 + (h)) * HTB)
#define PG8_STAGE(bufoff, gbase, voff) do { _Pragma("unroll") for (int _i = 0; _i < 2; ++_i) \
        __builtin_amdgcn_global_load_lds((const unsigned*)((const char*)(gbase) + (voff)[_i]), (PG8_LAS unsigned*)(lds + (bufoff) + ldsw + _i * 8192), 16, 0, 0); } while (0)
#define PG8_LDA(dst, b, h) do { _Pragma("unroll") for (int m = 0; m < 4; ++m) _Pragma("unroll") for (int k = 0; k < 2; ++k) dst[m][k] = *(const PG8_LAS bf16x8*)(lds + PG8_SA(b, h) + aoff + m * 2048 + k * 1024); } while (0)
#define PG8_LDB(dst, b, h) do { _Pragma("unroll") for (int n = 0; n < 2; ++n) _Pragma("unroll") for (int k = 0; k < 2; ++k) dst[n][k] = *(const PG8_LAS bf16x8*)(lds + PG8_SB(b, h) + boff + n * 2048 + k * 1024); } while (0)
#define PG8_MMA(ai, bj, At, Bt) do { __builtin_amdgcn_s_setprio(1); _Pragma("unroll") for (int m = 0; m < 4; ++m) _Pragma("unroll") for (int n = 0; n < 2; ++n) _Pragma("unroll") for (int k = 0; k < 2; ++k) \
        acc[ai][bj][m][n] = __builtin_amdgcn_mfma_f32_16x16x32_bf16(Bt[n][k], At[m][k], acc[ai][bj][m][n], 0, 0, 0); __builtin_amdgcn_s_setprio(0); } while (0)
#define PG8_WAIT_V(n) asm volatile("s_waitcnt vmcnt(" #n ")" ::: "memory")
#define PG8_WAIT_L(n) asm volatile("s_waitcnt lgkmcnt(" #n ")" ::: "memory")
#define PG8_BAR __builtin_amdgcn_s_barrier()
#define PG8_SCHED __builtin_amdgcn_sched_barrier(0)
    Unit cur, nxt; int ui = 0;
    if (!S.next(0, cur)) return;
    f32x4 acc[2][2][4][2];
#pragma unroll
    for (int a = 0; a < 2; ++a)
#pragma unroll
        for (int b = 0; b < 2; ++b)
#pragma unroll
            for (int m = 0; m < 4; ++m)
#pragma unroll
                for (int n = 0; n < 2; ++n) acc[a][b][m][n] = (f32x4){0.f, 0.f, 0.f, 0.f};
    bf16x8 At[4][2], B0[2][2], B1[2][2];
    const char* cA = (const char*)g.A + (size_t)cur.pm * tstep; const char* cB = (const char*)g.Bt + (size_t)cur.pn * tstep;
    S.a_ready(cur);
    if constexpr (SP2) {
        PG8_STAGE(PG8_SB(0, 0), cB, voffB); PG8_STAGE(PG8_SB(0, 1), cB + hstep, voffB); PG8_STAGE(PG8_SA(0, 0), cA, voffA); PG8_STAGE(PG8_SA(0, 1), cA + hstep, voffA);
        if (wr == 1) PG8_BAR;
        PG8_WAIT_V(2); PG8_BAR;
        PG8_STAGE(PG8_SB(1, 0), cB + kstep, voffB); PG8_STAGE(PG8_SA(1, 0), cA + kstep, voffA); PG8_STAGE(PG8_SB(1, 1), cB + hstep + kstep, voffB);
        PG8_WAIT_V(6); PG8_BAR;
    } else {
        PG8_STAGE(PG8_SB(0, 0), cB, voffB); PG8_STAGE(PG8_SA(0, 0), cA, voffA); PG8_STAGE(PG8_SB(0, 1), cB + hstep, voffB); PG8_STAGE(PG8_SA(0, 1), cA + hstep, voffA);
        if (wr == 1) PG8_BAR;
        PG8_WAIT_V(4); PG8_BAR;
        PG8_STAGE(PG8_SB(1, 0), cB + kstep, voffB); PG8_STAGE(PG8_SA(1, 0), cA + kstep, voffA); PG8_STAGE(PG8_SB(1, 1), cB + hstep + kstep, voffB);
        PG8_WAIT_V(6); PG8_BAR;
    }
    for (;;) {
        const bool has_next = S.next(ui + 1, nxt);
        const char* nA = has_next ? (const char*)g.A + (size_t)nxt.pm * tstep : cA; const char* nB = has_next ? (const char*)g.Bt + (size_t)nxt.pn * tstep : cB;
        for (int t = 0; t < nt; t += 2) {
            const bool last = (t == nt - 2);
            const char* a1 = cA + (size_t)(t + 1) * kstep;
            const char* a2 = last ? nA : cA + (size_t)(t + 2) * kstep; const char* b2 = last ? nB : cB + (size_t)(t + 2) * kstep;
            const char* a3 = a2 + kstep; const char* b3 = b2 + kstep;
            if (last && has_next) S.a_ready(nxt);
            if constexpr (SP2) {
            PG8_LDB(B0, 0, 0); PG8_LDB(B1, 0, 1); PG8_SCHED; PG8_LDA(At, 0, 0); PG8_STAGE(PG8_SA(1, 1), a1 + hstep, voffA);
            PG8_WAIT_V(8); PG8_WAIT_L(0); PG8_BAR; PG8_MMA(0, 0, At, B0); PG8_MMA(0, 1, At, B1); PG8_BAR; PG8_SCHED;
            PG8_LDA(At, 0, 1); PG8_STAGE(PG8_SB(0, 0), b2, voffB); PG8_STAGE(PG8_SB(0, 1), b2 + hstep, voffB); PG8_STAGE(PG8_SA(0, 0), a2, voffA);
            PG8_WAIT_V(8); PG8_WAIT_L(0); PG8_BAR; PG8_MMA(1, 0, At, B0); PG8_MMA(1, 1, At, B1); PG8_BAR; PG8_SCHED;
            PG8_LDB(B0, 1, 0); PG8_LDB(B1, 1, 1); PG8_SCHED; PG8_LDA(At, 1, 0); PG8_STAGE(PG8_SA(0, 1), a2 + hstep, voffA);
            PG8_WAIT_V(8); PG8_WAIT_L(0); PG8_BAR; PG8_MMA(0, 0, At, B0); PG8_MMA(0, 1, At, B1); PG8_BAR; PG8_SCHED;
            PG8_LDA(At, 1, 1); PG8_STAGE(PG8_SB(1, 0), b3, voffB); PG8_STAGE(PG8_SB(1, 1), b3 + hstep, voffB); PG8_STAGE(PG8_SA(1, 0), a3, voffA);
            PG8_WAIT_V(8); PG8_WAIT_L(0); PG8_BAR; PG8_MMA(1, 0, At, B0); PG8_MMA(1, 1, At, B1); PG8_BAR; PG8_SCHED;
            } else {
            PG8_LDB(B0, 0, 0); PG8_SCHED; PG8_LDA(At, 0, 0); PG8_STAGE(PG8_SA(1, 1), a1 + hstep, voffA);
            PG8_WAIT_L(8); PG8_BAR; PG8_WAIT_L(0); PG8_MMA(0, 0, At, B0); PG8_BAR; PG8_SCHED;
            PG8_LDB(B1, 0, 1); PG8_STAGE(PG8_SB(0, 0), b2, voffB);
            PG8_BAR; PG8_WAIT_L(0); PG8_MMA(0, 1, At, B1); PG8_BAR;
            PG8_LDA(At, 0, 1); PG8_STAGE(PG8_SA(0, 0), a2, voffA);
            PG8_BAR; PG8_WAIT_L(0); PG8_MMA(1, 0, At, B0); PG8_BAR; PG8_SCHED;
            PG8_STAGE(PG8_SB(0, 1), b2 + hstep, voffB);
            PG8_WAIT_V(6); PG8_BAR; PG8_MMA(1, 1, At, B1); PG8_BAR;
            PG8_LDB(B0, 1, 0); PG8_SCHED; PG8_LDA(At, 1, 0); PG8_STAGE(PG8_SA(0, 1), a2 + hstep, voffA);
            PG8_WAIT_L(8); PG8_BAR; PG8_WAIT_L(0); PG8_MMA(0, 0, At, B0); PG8_BAR; PG8_SCHED;
            PG8_LDB(B1, 1, 1); PG8_STAGE(PG8_SB(1, 0), b3, voffB);
            PG8_BAR; PG8_WAIT_L(0); PG8_MMA(0, 1, At, B1); PG8_BAR;
            PG8_LDA(At, 1, 1); PG8_STAGE(PG8_SA(1, 0), a3, voffA);
            PG8_BAR; PG8_WAIT_L(0); PG8_MMA(1, 0, At, B0); PG8_BAR; PG8_SCHED;
            PG8_STAGE(PG8_SB(1, 1), b3 + hstep, voffB);
            PG8_WAIT_V(6); PG8_BAR; PG8_MMA(1, 1, At, B1); PG8_BAR;
            }
        }
        if constexpr (ALIGN_EPI) { if (wr == 0) PG8_BAR; }
        if constexpr (!Epi::AFTER_DRAIN) { E(acc, cur, wr, wc, fr, fq); S.done(cur); }
        if (!has_next) break;
#pragma unroll
        for (int a = 0; a < 2; ++a)
#pragma unroll
            for (int b = 0; b < 2; ++b)
#pragma unroll
                for (int m = 0; m < 4; ++m)
#pragma unroll
                    for (int n = 0; n < 2; ++n) acc[a][b][m][n] = (f32x4){0.f, 0.f, 0.f, 0.f};
        cur = nxt; cA = nA; cB = nB; ++ui;
        if constexpr (ALIGN_EPI) { if (wr == 1) PG8_BAR; }
    }
    PG8_WAIT_V(0);
    if constexpr (!ALIGN_EPI) { if (wr == 0) PG8_BAR; }
    PG8_BAR;
    if constexpr (Epi::AFTER_DRAIN) { E.fused(acc, cur, wr, wc, fr, fq, lds, wid, lane); S.done(cur); }
#undef PG8_SA
#undef PG8_SB
#undef PG8_STAGE
#undef PG8_LDA
#undef PG8_LDB
#undef PG8_MMA
#undef PG8_WAIT_V
#undef PG8_WAIT_L
#undef PG8_BAR
#undef PG8_SCHED
}
}
#define LAS __attribute__((address_space(3)))
typedef unsigned short bf16;
typedef unsigned v4u __attribute__((ext_vector_type(4)));
typedef unsigned v2u __attribute__((ext_vector_type(2)));
typedef float f32x4 __attribute__((ext_vector_type(4)));
typedef short bf16x8 __attribute__((ext_vector_type(8)));

constexpr int NWAVES = 8, NT = 512;
constexpr int D = 1024, ML = 16384, MC = 1024, MA = ML + MC, SEQ = 4096, CTXL = 256, DFF = 2816, NFI = 2 * DFF;
constexpr float EPS = 1e-6f, LOG2E = 1.4426950408889634f;
constexpr size_t MiB = 1u << 20;
constexpr size_t WS_MOD = 1 * MiB;
constexpr size_t WS_STATS = 2 * MiB;
constexpr size_t WS_WS = 3 * MiB;
constexpr size_t WS_PRM = 3 * MiB + 512 * 1024;
constexpr int PRM_NMIX = 0, PRM_NFFN = 4096, PRM_LNV = 8192, PRM_BS = 9216, PRM_RPB = 10240, PRM_NFIN = 10240 + 14880, PRM_TOTAL = PRM_NFIN + 1024;
constexpr size_t WS_XW = 4 * MiB;
constexpr size_t WS_HN = 72 * MiB;
constexpr size_t WS_SCR = 106 * MiB;
constexpr size_t WS_H2 = WS_SCR;
constexpr size_t WS_QK = WS_SCR, WS_VT = WS_SCR + 68 * MiB, WS_O = WS_SCR + 102 * MiB;
constexpr size_t WS_UQ = WS_SCR, WS_GVT = WS_SCR + 34 * MiB, WS_Y = WS_SCR + 51 * MiB;
constexpr size_t WS_WIN = 242 * MiB;
constexpr size_t WS_WOAB = 248 * MiB;
constexpr size_t WS_WQKV = 252 * MiB;
constexpr size_t WS_WONA = 264 * MiB;
constexpr size_t WS_WFI = 268 * MiB;
constexpr size_t WS_WFO = 312 * MiB;
constexpr size_t WS_END = 334 * MiB;
constexpr int LDS_BYTES = 147456;

struct Args { const float* in[21]; float* out; unsigned char* ws; };

__device__ __forceinline__ float bf2f(unsigned b) { return __uint_as_float(b << 16); }
__device__ __forceinline__ unsigned pk2(float lo, float hi) { return pg8::cvt_pk_bf16(lo, hi); }
__device__ __forceinline__ float wave_sum(float v, int lane) {
    v += pg8::xshfl<1>(v); v += pg8::xshfl<2>(v); v += pg8::xshfl<4>(v); v += pg8::xshfl<8>(v); v += pg8::xshfl<16>(v); v += pg8::xshfl32(v, lane);
    return v;
}
#define LDS_WAIT() asm volatile("s_waitcnt lgkmcnt(0)" ::: "memory")

__device__ __forceinline__ void transpose_item(const float* W, int ldw, bf16* WT, int K, int k0, int n0, int drow0, LAS float* scr, int lane) {
#pragma unroll 8
    for (int i = 0; i < 32; ++i) { const int kk = 2 * i + (lane >> 5); scr[kk * 33 + (lane & 31)] = W[(size_t)(k0 + kk) * ldw + n0 + (lane & 31)]; }
    LDS_WAIT();
    const int c = lane & 7;
#pragma unroll
    for (int j = 0; j < 4; ++j) { const int n = (lane >> 3) + 8 * j; const LAS float* s = scr + (8 * c) * 33 + n;
        v4u o; o.x = pk2(s[0 * 33], s[1 * 33]); o.y = pk2(s[2 * 33], s[3 * 33]); o.z = pk2(s[4 * 33], s[5 * 33]); o.w = pk2(s[6 * 33], s[7 * 33]);
        *(v4u*)(WT + (size_t)(drow0 + n) * K + k0 + 8 * c) = o; }
    LDS_WAIT();
}

__device__ __forceinline__ void prologue(const Args& a, LAS unsigned char* lds, int tid, int lane, int wave, int bid, int G, int gw, int NGW) {
    unsigned char* ws = a.ws;
    {
        LAS float* scr = (LAS float*)(lds + wave * 16384);
        constexpr int I_IN = 16 * 32, I_SQ = 16 * 32, I_QKV = 16 * 96, I_FI = 16 * 176, I_FO = 44 * 32;
        constexpr int NITEMS = 2 * I_IN + 2 * I_SQ + 2 * I_QKV + 2 * I_SQ + 4 * I_FI + 4 * I_FO;
        for (int it = gw; it < NITEMS; it += NGW) {
            int r = it;
            if (r < 2 * I_IN) { const int j = r / I_IN; r -= j * I_IN; const int kb = r / 32, nb = r % 32, n0 = nb * 32;
                transpose_item(a.in[8] + (size_t)j * 1024 * 1536, 1536, (bf16*)(ws + WS_WIN) + (size_t)j * 1536 * 1024, 1024, kb * 64, n0, n0 < 512 ? n0 : n0 + 512, scr, lane); continue; } r -= 2 * I_IN;
            if (r < 2 * I_SQ) { const int j = r / I_SQ; r -= j * I_SQ; const int kb = r / 32, nb = r % 32;
                transpose_item(a.in[14] + (size_t)j * 1024 * 1024, 1024, (bf16*)(ws + WS_WOAB) + (size_t)j * 1024 * 1024, 1024, kb * 64, nb * 32, nb * 32, scr, lane); continue; } r -= 2 * I_SQ;
            if (r < 2 * I_QKV) { const int j = r / I_QKV; r -= j * I_QKV; const int kb = r / 96, nb = r % 96;
                transpose_item(a.in[15] + (size_t)j * 1024 * 3072, 3072, (bf16*)(ws + WS_WQKV) + (size_t)j * 3072 * 1024, 1024, kb * 64, nb * 32, nb * 32, scr, lane); continue; } r -= 2 * I_QKV;
            if (r < 2 * I_SQ) { const int j = r / I_SQ; r -= j * I_SQ; const int kb = r / 32, nb = r % 32;
                transpose_item(a.in[17] + (size_t)j * 1024 * 1024, 1024, (bf16*)(ws + WS_WONA) + (size_t)j * 1024 * 1024, 1024, kb * 64, nb * 32, nb * 32, scr, lane); continue; } r -= 2 * I_SQ;
            if (r < 4 * I_FI) { const int i = r / I_FI; r -= i * I_FI; const int kb = r / 176, nb = r % 176, n0 = nb * 32;
                const int jj = n0 < DFF ? n0 : n0 - DFF; const int drow0 = (jj >> 7) * 256 + (n0 < DFF ? 0 : 128) + (jj & 127);
                transpose_item(a.in[18] + (size_t)i * 1024 * NFI, NFI, (bf16*)(ws + WS_WFI) + (size_t)i * NFI * 1024, 1024, kb * 64, n0, drow0, scr, lane); continue; } r -= 4 * I_FI;
            { const int i = r / I_FO; r -= i * I_FO; const int kb = r / 32, nb = r % 32;
                transpose_item(a.in[19] + (size_t)i * DFF * 1024, 1024, (bf16*)(ws + WS_WFO) + (size_t)i * 1024 * DFF, DFF, kb * 64, nb * 32, nb * 32, scr, lane); }
        }
    }
    for (int e = bid * NT + tid; e < 2 * 4 * 128 * 128 / 2; e += G * NT) { const float2 v = *(const float2*)(a.in[10] + 2 * (size_t)e); ((unsigned*)(ws + WS_WS))[e] = pk2(v.x, v.y); }
    {
        float* prm = (float*)(ws + WS_PRM);
        for (int e = bid * NT + tid; e < PRM_TOTAL; e += G * NT) {
            float v;
            if (e < PRM_NFFN) v = a.in[6][e]; else if (e < PRM_LNV) v = a.in[7][e - PRM_NFFN]; else if (e < PRM_BS) v = a.in[9][e - PRM_LNV];
            else if (e < PRM_RPB) v = a.in[11][e - PRM_BS]; else if (e < PRM_NFIN) v = a.in[16][e - PRM_RPB] * LOG2E; else v = a.in[20][e - PRM_NFIN];
            prm[e] = v; }
        f32x4* xw = (f32x4*)(ws + WS_XW);
        for (int e = bid * NT + tid; e < MA * 256; e += G * NT) xw[e] = e < ML * 256 ? ((const f32x4*)a.in[0])[e] : ((const f32x4*)a.in[2])[e - ML * 256];
    }
    __syncthreads();
    for (int it = bid; it < 128; it += G) {
        const int j = it >> 6, g = (it >> 4) & 3, kb = it & 15, k0 = kb * 64;
        LAS float* wp = (LAS float*)lds; LAS float* wi = (LAS float*)(lds + 65536);
        const float* wpool = a.in[12] + (size_t)(j * 4 + g) * 16384;
#pragma unroll 4
        for (int i = 0; i < 32; ++i) wp[tid + 512 * i] = wpool[tid + 512 * i];
        const float* win = a.in[8] + (size_t)j * 1024 * 1536 + 1024 + g * 128;
#pragma unroll 4
        for (int i = 0; i < 16; ++i) { const int kk = (tid >> 7) + 4 * i, c = tid & 127; wi[kk * 129 + c] = win[(size_t)(k0 + kk) * 1536 + c]; }
        __syncthreads();
        const int kk = tid & 63, d0 = (tid >> 6) * 16;
        float acc[16];
#pragma unroll
        for (int i = 0; i < 16; ++i) acc[i] = 0.f;
        for (int c = 0; c < 128; ++c) { const float av = wi[kk * 129 + c];
#pragma unroll
            for (int i = 0; i < 16; ++i) acc[i] += av * wp[c * 128 + d0 + i]; }
        const float* ps = a.in[13] + j * 512 + g * 128 + d0;
        bf16* out = (bf16*)(ws + WS_WIN) + (size_t)j * 1536 * 1024 + (size_t)(512 + g * 128 + d0) * 1024 + k0 + kk;
#pragma unroll
        for (int i = 0; i < 16; ++i) out[(size_t)i * 1024] = (bf16)(pk2(acc[i] * ps[i], 0.f) & 0xffffu);
        __syncthreads();
    }
    {
        LAS float* sv = (LAS float*)lds;
        LAS float* red = (LAS float*)(lds + 20480);
        for (int e = tid; e < 5 * 1024; e += NT) { const float v = e < 4096 ? a.in[1][e] : a.in[3][e - 4096]; sv[e] = pg8::silu_f(v); }
        __syncthreads();
        for (int it = bid; it < 4 * 192; it += G) {
            const int layer = it / 192, n0 = (it % 192) * 32, col = tid & 31, ks = tid >> 5;
            const float* wm = a.in[4] + ((size_t)layer * 1024 + ks * 64) * 6144 + n0 + col;
            float acc[5] = {0.f, 0.f, 0.f, 0.f, 0.f};
#pragma unroll 8
            for (int k = 0; k < 64; ++k) { const float w = wm[(size_t)k * 6144];
#pragma unroll
                for (int c = 0; c < 5; ++c) acc[c] += sv[c * 1024 + ks * 64 + k] * w; }
#pragma unroll
            for (int c = 0; c < 5; ++c) red[(ks * 5 + c) * 32 + col] = acc[c];
            __syncthreads();
            if (tid < 160) { const int c = tid >> 5; float s = a.in[5][layer * 6144 + n0 + col];
#pragma unroll
                for (int q = 0; q < 16; ++q) s += red[(q * 5 + c) * 32 + col];
                ((float*)(ws + WS_MOD))[(size_t)(layer * 5 + c) * 6144 + n0 + col] = s; }
            __syncthreads();
        }
    }
}

__device__ __forceinline__ void rowpass(unsigned char* ws, int layer, int which, int Mrows, int lane, int gw, int NGW) {
    float* XW = (float*)(ws + WS_XW); bf16* HN = (bf16*)(ws + WS_HN);
    const float* gn = (const float*)(ws + WS_PRM) + (which ? PRM_NFFN : PRM_NMIX) + layer * 1024;
    const float* mod = (const float*)(ws + WS_MOD) + (size_t)layer * 5 * 6144 + (which ? 3 : 0) * 1024;
    f32x4 g4[4];
#pragma unroll
    for (int j = 0; j < 4; ++j) g4[j] = *(const f32x4*)(gn + 4 * lane + 256 * j);
    for (int m = gw; m < Mrows; m += NGW) {
        const float* src = XW + (size_t)m * D;
        const int cond = m < ML ? (m >> 12) : 4;
        const float* sh = mod + cond * 6144; const float* sc = sh + 1024;
        f32x4 v[4]; float s = 0.f;
#pragma unroll
        for (int j = 0; j < 4; ++j) { v[j] = *(const f32x4*)(src + 4 * lane + 256 * j); s += (v[j].x * v[j].x + v[j].y * v[j].y) + (v[j].z * v[j].z + v[j].w * v[j].w); }
        const float rstd = 1.0f / sqrtf(wave_sum(s, lane) * (1.f / D) + EPS);
#pragma unroll
        for (int j = 0; j < 4; ++j) {
            const f32x4 s4 = *(const f32x4*)(sc + 4 * lane + 256 * j), h4 = *(const f32x4*)(sh + 4 * lane + 256 * j);
            const f32x4 o = (v[j] * rstd) * g4[j] * (s4 + 1.0f) + h4;
            v2u w; w.x = pk2(o.x, o.y); w.y = pk2(o.z, o.w);
            *(v2u*)(HN + (size_t)m * D + 4 * lane + 256 * j) = w; }
    }
}

__device__ __forceinline__ void final_norm(unsigned char* ws, float* out, int lane, int gw, int NGW) {
    const float* XW = (const float*)(ws + WS_XW); const float* gn = (const float*)(ws + WS_PRM) + PRM_NFIN;
    f32x4 g4[4];
#pragma unroll
    for (int j = 0; j < 4; ++j) g4[j] = *(const f32x4*)(gn + 4 * lane + 256 * j);
    for (int m = gw; m < ML; m += NGW) {
        f32x4 v[4]; float s = 0.f;
#pragma unroll
        for (int j = 0; j < 4; ++j) { v[j] = *(const f32x4*)(XW + (size_t)m * D + 4 * lane + 256 * j); s += (v[j].x * v[j].x + v[j].y * v[j].y) + (v[j].z * v[j].z + v[j].w * v[j].w); }
        const float rstd = 1.0f / sqrtf(wave_sum(s, lane) * (1.f / D) + EPS);
#pragma unroll
        for (int j = 0; j < 4; ++j) *(f32x4*)(out + (size_t)m * D + 4 * lane + 256 * j) = (v[j] * rstd) * g4[j];
    }
}

__device__ __forceinline__ void mix_phase(unsigned char* ws, LAS unsigned char* lds, int j, int tid, int lane, int wave, int bid, int G) {
    const float* prm = (const float*)(ws + WS_PRM);
    const bf16* UQ = (const bf16*)(ws + WS_UQ); const bf16* GVT = (const bf16*)(ws + WS_GVT); bf16* Y = (bf16*)(ws + WS_Y);
    const float* stats = (const float*)(ws + WS_STATS); const bf16* WSb = (const bf16*)(ws + WS_WS);
    LAS float* st = (LAS float*)lds;
    const int li = lane & 15, gq = lane >> 4;
    for (int u = bid; u < 136 * 4; u += G) {
        const int chunk = u >> 2, g = u & 3, token0 = chunk * 128;
        int s0, L, seqbase;
        if (chunk < 128) { s0 = (chunk & 31) * 128; L = SEQ; seqbase = (chunk >> 5) * SEQ; } else { const int cc = chunk - 128; s0 = (cc & 1) * 128; L = CTXL; seqbase = ML + (cc >> 1) * CTXL; }
        __syncthreads();
        if (tid < 128) { const float* p = stats + (size_t)(token0 + tid) * 8; const f32x4 p0 = *(const f32x4*)p, p1 = *(const f32x4*)(p + 4);
            const float S = (p0.x + p0.z) + (p1.x + p1.z), Q = (p0.y + p0.w) + (p1.y + p1.w);
            const float mean = S * (1.f / 512.f); const float var = fmaxf(Q * (1.f / 512.f) - mean * mean, 0.f);
            st[2 * tid] = mean; st[2 * tid + 1] = 1.0f / sqrtf(var + EPS); }
        __syncthreads();
        {
            const int c = 16 * wave + li;
            const float lnv = prm[PRM_LNV + j * 512 + g * 128 + c];
            f32x4 acc[8];
#pragma unroll
            for (int ib = 0; ib < 8; ++ib) acc[ib] = (f32x4){0.f, 0.f, 0.f, 0.f};
#pragma unroll
            for (int ks = 0; ks < 4; ++ks) {
                const v4u raw = *(const v4u*)(GVT + (size_t)(g * 128 + c) * MA + token0 + 32 * ks + 8 * gq);
                const LAS f32x4* sp = (const LAS f32x4*)(st + 2 * (32 * ks + 8 * gq));
                const f32x4 m0 = sp[0], m1 = sp[1], m2 = sp[2], m3 = sp[3];
                v4u an;
                an.x = pk2((bf2f(raw.x & 0xffffu) - m0.x) * m0.y * lnv, (bf2f(raw.x >> 16) - m0.z) * m0.w * lnv);
                an.y = pk2((bf2f(raw.y & 0xffffu) - m1.x) * m1.y * lnv, (bf2f(raw.y >> 16) - m1.z) * m1.w * lnv);
                an.z = pk2((bf2f(raw.z & 0xffffu) - m2.x) * m2.y * lnv, (bf2f(raw.z >> 16) - m2.z) * m2.w * lnv);
                an.w = pk2((bf2f(raw.w & 0xffffu) - m3.x) * m3.y * lnv, (bf2f(raw.w >> 16) - m3.z) * m3.w * lnv);
                const bf16x8 af = __builtin_bit_cast(bf16x8, an);
#pragma unroll
                for (int ib = 0; ib < 8; ++ib) {
                    const bf16x8 bfr = *(const bf16x8*)(WSb + ((size_t)((j * 4 + g) * 128 + 16 * ib + li)) * 128 + 32 * ks + 8 * gq);
                    acc[ib] = __builtin_amdgcn_mfma_f32_16x16x32_bf16(af, bfr, acc[ib], 0, 0, 0); }
            }
            const int cc = g * 128 + 16 * wave + 4 * gq;
#pragma unroll
            for (int ib = 0; ib < 8; ++ib) {
                const int tok = token0 + 16 * ib + li;
                const float bs = prm[PRM_BS + (j * 4 + g) * 128 + 16 * ib + li];
                const v2u uu = *(const v2u*)(UQ + (size_t)tok * 1024 + cc);
                v2u o; o.x = pk2(bf2f(uu.x & 0xffffu) * (acc[ib][0] + bs), bf2f(uu.x >> 16) * (acc[ib][1] + bs));
                o.y = pk2(bf2f(uu.y & 0xffffu) * (acc[ib][2] + bs), bf2f(uu.y >> 16) * (acc[ib][3] + bs));
                *(v2u*)(Y + (size_t)tok * 1024 + cc) = o; }
        }
        {
            const int c8 = tid & 15, rg = tid >> 4, hw = 1 << g;
            const int t0 = s0 + 4 * rg;
            const int rlo = max(t0 - hw, 0), rhi = min(t0 + 3 + hw, L);
            float sum[4][8], self[4][8];
#pragma unroll
            for (int tt = 0; tt < 4; ++tt)
#pragma unroll
                for (int e = 0; e < 8; ++e) { sum[tt][e] = 0.f; self[tt][e] = 0.f; }
            const bf16* qb = UQ + (size_t)seqbase * 1024 + 512 + g * 128 + c8 * 8;
            for (int r = rlo; r < rhi; ++r) {
                const v4u raw = *(const v4u*)(qb + (size_t)r * 1024);
                float f[8]; f[0] = bf2f(raw.x & 0xffffu); f[1] = bf2f(raw.x >> 16); f[2] = bf2f(raw.y & 0xffffu); f[3] = bf2f(raw.y >> 16);
                f[4] = bf2f(raw.z & 0xffffu); f[5] = bf2f(raw.z >> 16); f[6] = bf2f(raw.w & 0xffffu); f[7] = bf2f(raw.w >> 16);
#pragma unroll
                for (int tt = 0; tt < 4; ++tt) { const int t = t0 + tt; const bool in = (r >= t - hw) && (r < t + hw); const bool me = (r == t);
#pragma unroll
                    for (int e = 0; e < 8; ++e) { sum[tt][e] += in ? f[e] : 0.f; self[tt][e] = me ? f[e] : self[tt][e]; } }
            }
#pragma unroll
            for (int tt = 0; tt < 4; ++tt) { const int t = t0 + tt; const int lo = max(t - hw, 0), hi = min(t + hw, L); const float inv = 1.0f / (float)(hi - lo);
                v4u o; o.x = pk2(sum[tt][0] * inv - self[tt][0], sum[tt][1] * inv - self[tt][1]); o.y = pk2(sum[tt][2] * inv - self[tt][2], sum[tt][3] * inv - self[tt][3]);
                o.z = pk2(sum[tt][4] * inv - self[tt][4], sum[tt][5] * inv - self[tt][5]); o.w = pk2(sum[tt][6] * inv - self[tt][6], sum[tt][7] * inv - self[tt][7]);
                *(v4u*)(Y + (size_t)(seqbase + t) * 1024 + 512 + g * 128 + c8 * 8) = o; }
        }
    }
}

constexpr int ATT_RPB = 0, ATT_CK = 4096, ATT_CKP = 144, ATT_CV = 40960, ATT_CVP = 528;
template <bool CTXQ>
__device__ __forceinline__ void attn_wave(const bf16* QK, const bf16* VT, bf16* O, LAS unsigned char* lds, int b, int h, int r, int jg, int qtok0, int lane) {
    const int li = lane & 15, gq = lane >> 4;
    constexpr int NCH = CTXQ ? 8 : 16, NNB = CTXQ ? 0 : 8;
    const LAS float* rpbL = (const LAS float*)(lds + ATT_RPB);
    bf16x8 qf[2];
    { const bf16* qp = QK + (size_t)(qtok0 + li) * 2048 + h * 64 + 8 * gq; qf[0] = *(const bf16x8*)qp; qf[1] = *(const bf16x8*)(qp + 32); }
    const int kwin0 = jg == 0 ? 0 : (jg == 1 ? 8 : (jg == 2 ? 24 : 32));
    const int rs = min(max(r - 4, 0), 56);
    const int kofs = (li >> 2) * 8 + (li & 3);
    const int nbbase = b * SEQ + rs * 64 + kwin0;
    const bf16* kg = QK + (size_t)(nbbase + kofs) * 2048 + 1024 + h * 64 + 8 * gq;
    const LAS unsigned char* kl = lds + ATT_CK + kofs * ATT_CKP + gq * 16;
    f32x4 s[NCH][2];
#define ATT_QK_CTX(cc) do { _Pragma("unroll") for (int t = 0; t < 2; ++t) { \
        const bf16x8 k0 = *(const LAS bf16x8*)(kl + ((cc) * 32 + 4 * t) * ATT_CKP), k1 = *(const LAS bf16x8*)(kl + ((cc) * 32 + 4 * t) * ATT_CKP + 64); \
        f32x4 c = (f32x4){0.f, 0.f, 0.f, 0.f}; c = __builtin_amdgcn_mfma_f32_16x16x32_bf16(k0, qf[0], c, 0, 0, 0); c = __builtin_amdgcn_mfma_f32_16x16x32_bf16(k1, qf[1], c, 0, 0, 0); s[NNB + (cc)][t] = c; } } while (0)
    if constexpr (!CTXQ) {
        bf16x8 kb[2][8];
#define ATT_LOADK(buf, p) do { _Pragma("unroll") for (int c2 = 0; c2 < 2; ++c2) _Pragma("unroll") for (int t = 0; t < 2; ++t) _Pragma("unroll") for (int ks = 0; ks < 2; ++ks) \
        kb[buf][c2 * 4 + t * 2 + ks] = *(const bf16x8*)(kg + (size_t)((2 * (p) + c2) * 64 + 4 * t) * 2048 + ks * 32); __builtin_amdgcn_sched_barrier(0); } while (0)
#define ATT_QK_NB(buf, p) do { _Pragma("unroll") for (int c2 = 0; c2 < 2; ++c2) _Pragma("unroll") for (int t = 0; t < 2; ++t) { \
        f32x4 c = (f32x4){0.f, 0.f, 0.f, 0.f}; c = __builtin_amdgcn_mfma_f32_16x16x32_bf16(kb[buf][c2 * 4 + t * 2], qf[0], c, 0, 0, 0); \
        c = __builtin_amdgcn_mfma_f32_16x16x32_bf16(kb[buf][c2 * 4 + t * 2 + 1], qf[1], c, 0, 0, 0); s[2 * (p) + c2][t] = c; } __builtin_amdgcn_sched_barrier(0); } while (0)
        ATT_LOADK(0, 0); ATT_QK_CTX(0); ATT_QK_CTX(1);
        ATT_LOADK(1, 1); ATT_QK_NB(0, 0); ATT_QK_CTX(2); ATT_QK_CTX(3);
        ATT_LOADK(0, 2); ATT_QK_NB(1, 1); ATT_QK_CTX(4); ATT_QK_CTX(5);
        ATT_LOADK(1, 3); ATT_QK_NB(0, 2); ATT_QK_CTX(6); ATT_QK_CTX(7);
        ATT_QK_NB(1, 3);
#undef ATT_LOADK
#undef ATT_QK_NB
        const int cq = 16 * jg + li, cs = min(max(cq - 8, 0), 48);
#pragma unroll
        for (int ch = 0; ch < NNB; ++ch) { const int dr = rs + ch - r + 7;
#pragma unroll
            for (int t = 0; t < 2; ++t)
#pragma unroll
                for (int e = 0; e < 4; ++e) { const int kc = kwin0 + 8 * gq + 4 * t + e; const bool valid = (kc >= cs) && (kc < cs + 16);
                    const int dc = min(max(kc - cq + 15, 0), 30); const float bias = rpbL[dr * 31 + dc];
                    s[ch][t][e] = valid ? s[ch][t][e] + bias : -1e30f; } }
    } else {
#pragma unroll
        for (int cc = 0; cc < 8; ++cc) ATT_QK_CTX(cc);
    }
#undef ATT_QK_CTX
    float mx = -1e30f;
#pragma unroll
    for (int ch = 0; ch < NCH; ++ch)
#pragma unroll
        for (int t = 0; t < 2; ++t)
#pragma unroll
            for (int e = 0; e < 4; ++e) mx = fmaxf(mx, s[ch][t][e]);
    mx = fmaxf(mx, pg8::xshfl<16>(mx)); mx = fmaxf(mx, pg8::xshfl32(mx, lane));
    float lsum = 0.f; bf16x8 pf[NCH];
#pragma unroll
    for (int ch = 0; ch < NCH; ++ch) { float p[8];
#pragma unroll
        for (int t = 0; t < 2; ++t)
#pragma unroll
            for (int e = 0; e < 4; ++e) { p[4 * t + e] = __builtin_amdgcn_exp2f(s[ch][t][e] - mx); lsum += p[4 * t + e]; }
        v4u w; w.x = pk2(p[0], p[1]); w.y = pk2(p[2], p[3]); w.z = pk2(p[4], p[5]); w.w = pk2(p[6], p[7]);
        pf[ch] = __builtin_bit_cast(bf16x8, w); }
    lsum += pg8::xshfl<16>(lsum); lsum += pg8::xshfl32(lsum, lane);
    const float inv = 1.0f / lsum;
    f32x4 o[4];
    const LAS unsigned char* vl = lds + ATT_CV + li * ATT_CVP + gq * 16;
    if constexpr (!CTXQ) {
        bf16x8 vb[2][2][8];
        const bf16* vg = VT + (size_t)(h * 64 + li) * MA + nbbase + 8 * gq;
#define ATT_LOADV(buf, half) do { _Pragma("unroll") for (int d2 = 0; d2 < 2; ++d2) _Pragma("unroll") for (int ch = 0; ch < 8; ++ch) \
        vb[buf][d2][ch] = *(const bf16x8*)(vg + (size_t)(2 * (half) + d2) * 16 * MA + ch * 64); __builtin_amdgcn_sched_barrier(0); } while (0)
#define ATT_PV_CTX(half) do { _Pragma("unroll") for (int d2 = 0; d2 < 2; ++d2) { const int db = 2 * (half) + d2; f32x4 oo = (f32x4){0.f, 0.f, 0.f, 0.f}; \
        _Pragma("unroll") for (int cc = 0; cc < 8; ++cc) { const bf16x8 vf = *(const LAS bf16x8*)(vl + db * 16 * ATT_CVP + cc * 64); oo = __builtin_amdgcn_mfma_f32_16x16x32_bf16(vf, pf[8 + cc], oo, 0, 0, 0); } \
        o[db] = oo; } __builtin_amdgcn_sched_barrier(0); } while (0)
#define ATT_PV_NB(buf, half) do { _Pragma("unroll") for (int d2 = 0; d2 < 2; ++d2) _Pragma("unroll") for (int ch = 0; ch < 8; ++ch) \
        o[2 * (half) + d2] = __builtin_amdgcn_mfma_f32_16x16x32_bf16(vb[buf][d2][ch], pf[ch], o[2 * (half) + d2], 0, 0, 0); __builtin_amdgcn_sched_barrier(0); } while (0)
        ATT_LOADV(0, 0); ATT_PV_CTX(0); ATT_LOADV(1, 1); ATT_PV_NB(0, 0); ATT_PV_CTX(1); ATT_PV_NB(1, 1);
#undef ATT_LOADV
#undef ATT_PV_CTX
#undef ATT_PV_NB
    } else {
#pragma unroll
        for (int db = 0; db < 4; ++db) { f32x4 oo = (f32x4){0.f, 0.f, 0.f, 0.f};
#pragma unroll
            for (int cc = 0; cc < 8; ++cc) { const bf16x8 vf = *(const LAS bf16x8*)(vl + db * 16 * ATT_CVP + cc * 64); oo = __builtin_amdgcn_mfma_f32_16x16x32_bf16(vf, pf[cc], oo, 0, 0, 0); }
            o[db] = oo; }
    }
#pragma unroll
    for (int db = 0; db < 4; ++db) { v2u w; w.x = pk2(o[db][0] * inv, o[db][1] * inv); w.y = pk2(o[db][2] * inv, o[db][3] * inv);
        *(v2u*)(O + (size_t)(qtok0 + li) * 1024 + h * 64 + 16 * db + 4 * gq) = w; }
}

__device__ __forceinline__ void attn_phase(unsigned char* ws, LAS unsigned char* lds, int j, bool ctxq, int tid, int lane, int wave, int vcu, int G) {
    const bf16* QK = (const bf16*)(ws + WS_QK); const bf16* VT = (const bf16*)(ws + WS_VT); bf16* O = (bf16*)(ws + WS_O);
    int Gl = G; asm volatile("" : "+s"(Gl));
    const int per = __builtin_amdgcn_readfirstlane((2048 + Gl - 1) / Gl);
    int cur_bh = -1;
    for (int u = vcu * per; u < min((vcu + 1) * per, 2048); ++u) {
        const int bh = u >> 5, rp = u & 31, b = bh >> 4, h = bh & 15;
        if (bh != cur_bh) {
            cur_bh = bh;
            __syncthreads();
            if (tid < 465) ((LAS float*)(lds + ATT_RPB))[tid] = ((const float*)(ws + WS_PRM))[PRM_RPB + (j * 16 + h) * 465 + tid];
            const int cxbase = ML + b * CTXL;
#pragma unroll
            for (int i = 0; i < 4; ++i) { const int c = tid + 512 * i;
                { const int key = c >> 3, part = c & 7; *(LAS v4u*)(lds + ATT_CK + key * ATT_CKP + part * 16) = *(const v4u*)(QK + (size_t)(cxbase + key) * 2048 + 1024 + h * 64 + part * 8); }
                { const int d = c >> 5, part = c & 31; *(LAS v4u*)(lds + ATT_CV + d * ATT_CVP + part * 16) = *(const v4u*)(VT + (size_t)(h * 64 + d) * MA + cxbase + part * 8); } }
            __syncthreads();
        }
        const int r = 2 * rp + (wave >> 2), jg = wave & 3;
        attn_wave<false>(QK, VT, O, lds, b, h, r, jg, b * SEQ + r * 64 + 16 * jg, lane);
        if (ctxq && (rp & 15) == 0) attn_wave<true>(QK, VT, O, lds, b, h, 0, 0, ML + b * CTXL + 128 * (rp >> 4) + 16 * wave, lane);
    }
}

#define XB_TMO      128
#define XB_XCNT(j)  (256  + 64 * (j))
#define XB_XSUB(j)  (1280 + 64 * (j))
#define XB_XGEN(j)  (2304 + 64 * (j))
#define XB_TOP      3328
#define XB_TOPGEN   3392
#define XCD_BAR_WORDS 3456
#define XB_SPIN_CAP (1u << 18)

__device__ __forceinline__ unsigned xb_ld(unsigned* p)              { return __hip_atomic_load(p, __ATOMIC_RELAXED, __HIP_MEMORY_SCOPE_AGENT); }
__device__ __forceinline__ unsigned xb_add(unsigned* p, unsigned v) { return __hip_atomic_fetch_add(p, v, __ATOMIC_RELAXED, __HIP_MEMORY_SCOPE_AGENT); }
__device__ __forceinline__ unsigned xb_xcc_id() { return (unsigned)__builtin_amdgcn_s_getreg((3 << 11) | 20) & 0xFu; }
#define XB_SPIN(cond, bar) do { unsigned _sp = 0; while (cond) { __builtin_amdgcn_s_sleep(1); \
    if ((++_sp & 255u) == 0u) { if (xb_ld(&(bar)[XB_TMO])) break; if (_sp > XB_SPIN_CAP) { atomicAdd(&(bar)[XB_TMO], 1u); break; } } } } while (0)

struct XcdBarrier {
    unsigned* bar; unsigned x;
    volatile LAS unsigned* st;
};

__device__ __forceinline__ XcdBarrier xcd_barrier_post(unsigned* bar, volatile LAS unsigned* st) {
    XcdBarrier b; b.bar = bar; b.x = xb_xcc_id(); b.st = st;
    if (threadIdx.x == 0) (void)xb_add(&bar[XB_XCNT(b.x)], 1u);
    return b;
}
__device__ __forceinline__ void xcd_barrier_complete(unsigned* bar, unsigned x, unsigned& nloc, unsigned& nx) {
    const unsigned G = gridDim.x * gridDim.y * gridDim.z;
    unsigned sum, cnt, mine, sp = 0u;
    for (;;) {
        sum = 0u; cnt = 0u; mine = 0u;
#pragma unroll
        for (unsigned j = 0; j < 16; ++j) { const unsigned c = xb_ld(&bar[XB_XCNT(j)]); sum += c; cnt += (c > 0u) ? 1u : 0u; mine = (j == x) ? c : mine; }
        if (sum == G) break;
        __builtin_amdgcn_s_sleep(1);
        if ((++sp & 255u) == 0u) { if (xb_ld(&bar[XB_TMO])) break; if (sp > XB_SPIN_CAP) { atomicAdd(&bar[XB_TMO], 1u); break; } }
    }
    nloc = mine > 0u ? mine : 1u; nx = cnt > 0u ? cnt : 1u;
}

__device__ __forceinline__ void xcd_barrier(const XcdBarrier& b) {
    asm volatile("s_waitcnt vmcnt(0)" ::: "memory");
    __syncthreads();
    if (threadIdx.x == 0) {
        unsigned* bar = b.bar;
        __builtin_amdgcn_s_waitcnt(0);
        unsigned nloc = b.st[0], nx = b.st[1];
        if (nloc == 0u) { xcd_barrier_complete(bar, b.x, nloc, nx); b.st[0] = nloc; b.st[1] = nx; }
        const unsigned old = xb_add(&bar[XB_XSUB(b.x)], 1u);
        const unsigned gen = old / nloc;
        if (old + 1u == (gen + 1u) * nloc) {
            __builtin_amdgcn_fence(__ATOMIC_RELEASE, "agent");
            asm volatile("s_waitcnt vmcnt(0)" ::: "memory");
            const unsigned og = xb_add(&bar[XB_TOP], 1u);
            const unsigned tg = og / nx;
            if (og + 1u == (tg + 1u) * nx) xb_add(&bar[XB_TOPGEN], 1u);
            else XB_SPIN(xb_ld(&bar[XB_TOPGEN]) == tg, bar);
            __builtin_amdgcn_fence(__ATOMIC_ACQUIRE, "agent");
            xb_add(&bar[XB_XGEN(b.x)], 1u);
            asm volatile("s_waitcnt vmcnt(0)" ::: "memory");
        } else {
            XB_SPIN(xb_ld(&bar[XB_XGEN(b.x)]) == gen, bar);
            __builtin_amdgcn_fence(__ATOMIC_ACQUIRE, "agent");
            asm volatile("s_waitcnt vmcnt(0)" ::: "memory");
        }
    }
    __syncthreads();
}

constexpr size_t WS_BAR = 0;
__global__ void __launch_bounds__(NT, 2) mega(Args a) {
    extern __shared__ __attribute__((aligned(16))) unsigned char lds_raw[];
    LAS unsigned char* lds = (LAS unsigned char*)lds_raw;
    cg::grid_group grid = cg::this_grid();
#ifndef PROBE_SYNC
#define PROBE_SYNC 0
#endif
#ifndef PROBE_ATTN
#define PROBE_ATTN 0
#endif
#ifndef PROBE_MIX
#define PROBE_MIX 0
#endif
#ifndef PROBE_ROW
#define PROBE_ROW 0
#endif
#ifndef PROBE_PRO
#define PROBE_PRO 0
#endif
    volatile LAS unsigned* bst = (volatile LAS unsigned*)(lds + 131072);
    if (threadIdx.x < 2) bst[threadIdx.x] = 0u;
    if (blockIdx.x == 0) for (int t = threadIdx.x; t < XCD_BAR_WORDS; t += NT) __hip_atomic_store((unsigned*)(a.ws + WS_BAR) + t, 0u, __ATOMIC_RELAXED, __HIP_MEMORY_SCOPE_AGENT);
    XcdBarrier xbar;
#define GSYNC() do { xcd_barrier(xbar); if (PROBE_SYNC) xcd_barrier(xbar); } while (0)
    const int G = gridDim.x, bid = blockIdx.x;
    const int vcu = (G % 8 == 0) ? (bid % 8) * (G / 8) + bid / 8 : bid;
    const int NGW = G * NWAVES;
#define TIDS() int tid = threadIdx.x; asm volatile("" : "+v"(tid)); int vcul = vcu; asm volatile("" : "+s"(vcul)); const int lane = tid & 63, wave = __builtin_amdgcn_readfirstlane(tid >> 6), gw = vcul * NWAVES + wave; (void)lane; (void)gw
    unsigned char* ws = a.ws; float* out = a.out;
    bf16* HN = (bf16*)(ws + WS_HN);
    const float* MOD = (const float*)(ws + WS_MOD);

    { TIDS(); prologue(a, lds, tid, lane, wave, bid, G, gw, NGW); if (PROBE_PRO) { __syncthreads(); prologue(a, lds, tid, lane, wave, bid, G, gw, NGW); } }
    grid.sync();
    xbar = xcd_barrier_post((unsigned*)(a.ws + WS_BAR), bst);
#pragma unroll 1
    for (int i = 0; i < 4; ++i) {
        const bool odd = (i & 1) != 0, last = (i == 3); const int j = i >> 1; const int Mact = last ? ML : MA;
        { TIDS(); rowpass(ws, i, 0, MA, lane, gw, NGW); if (PROBE_ROW) rowpass(ws, i, 0, MA, lane, gw, NGW); }
        GSYNC();
        if (odd) {
            { pg8::Gemm g{HN, (const bf16*)(ws + WS_WQKV) + (size_t)j * 3072 * 1024, MA, 2048, 1024}; pg8::StaticOrder S; S.init(MA, 2048, G, bid);
              pg8::EpiStoreBf16 E{(bf16*)(ws + WS_QK), 2048, 0, 4, 0.125f * LOG2E};
              pg8::gemm_phase<pg8::EpiStoreBf16, pg8::StaticOrder, true, true>(lds, g, S, E); }
            { pg8::Gemm g{(const bf16*)(ws + WS_WQKV) + (size_t)j * 3072 * 1024 + (size_t)2048 * 1024, HN, 1024, MA, 1024}; pg8::StaticOrder S; S.init(1024, MA, G, bid);
              pg8::EpiStoreBf16 E{(bf16*)(ws + WS_VT), MA, 0, 0, 1.f};
              pg8::gemm_phase<pg8::EpiStoreBf16, pg8::StaticOrder, true, true>(lds, g, S, E); }
        } else {
            { pg8::Gemm g{HN, (const bf16*)(ws + WS_WIN) + (size_t)j * 1536 * 1024, MA, 1024, 1024}; pg8::StaticOrder S; S.init(MA, 1024, G, bid);
              pg8::EpiStoreBf16 E{(bf16*)(ws + WS_UQ), 1024, 2, 0, 1.f};
              pg8::gemm_phase<pg8::EpiStoreBf16, pg8::StaticOrder, true, true>(lds, g, S, E); }
            { pg8::Gemm g{(const bf16*)(ws + WS_WIN) + (size_t)j * 1536 * 1024 + (size_t)1024 * 1024, HN, 512, MA, 1024}; pg8::StaticOrder S; S.init(512, MA, G, bid);
              pg8::EpiGVt E{(bf16*)(ws + WS_GVT), MA, (float*)(ws + WS_STATS)};
              pg8::gemm_phase<pg8::EpiGVt, pg8::StaticOrder, true, true>(lds, g, S, E); }
        }
        GSYNC();
        if (odd) { TIDS(); attn_phase(ws, lds, j, !last, tid, lane, wave, vcul, G); if (PROBE_ATTN) { __syncthreads(); attn_phase(ws, lds, j, !last, tid, lane, wave, vcul, G); } }
        else { TIDS(); mix_phase(ws, lds, j, tid, lane, wave, bid, G); if (PROBE_MIX) { __syncthreads(); mix_phase(ws, lds, j, tid, lane, wave, bid, G); } }
        GSYNC();
        { pg8::Gemm g{odd ? (const bf16*)(ws + WS_O) : (const bf16*)(ws + WS_Y), odd ? (const bf16*)(ws + WS_WONA) + (size_t)j * 1024 * 1024 : (const bf16*)(ws + WS_WOAB) + (size_t)j * 1024 * 1024, Mact, 1024, 1024};
          pg8::StaticOrder S; S.init(Mact, 1024, G, bid);
          pg8::EpiResGate E{(float*)(ws + WS_XW), MOD + (size_t)i * 5 * 6144 + 2 * 1024};
          pg8::gemm_phase<pg8::EpiResGate, pg8::StaticOrder, true, true>(lds, g, S, E); }
        GSYNC();
        { TIDS(); rowpass(ws, i, 1, Mact, lane, gw, NGW); if (PROBE_ROW) rowpass(ws, i, 1, Mact, lane, gw, NGW); }
        GSYNC();
        { pg8::Gemm g{HN, (const bf16*)(ws + WS_WFI) + (size_t)i * NFI * 1024, Mact, NFI, 1024}; pg8::StaticOrder S; S.init(Mact, NFI, G, bid);
          pg8::EpiSwiGLU E{(bf16*)(ws + WS_H2), DFF};
          pg8::gemm_phase<pg8::EpiSwiGLU, pg8::StaticOrder, true, true>(lds, g, S, E); }
        GSYNC();
        { pg8::Gemm g{(const bf16*)(ws + WS_H2), (const bf16*)(ws + WS_WFO) + (size_t)i * 1024 * DFF, Mact, 1024, DFF}; pg8::StaticOrder S; S.init(Mact, 1024, G, bid);
          pg8::EpiResGate E{(float*)(ws + WS_XW), MOD + (size_t)i * 5 * 6144 + 5 * 1024};
          pg8::gemm_phase<pg8::EpiResGate, pg8::StaticOrder, true, true>(lds, g, S, E); }
        GSYNC();
    }
    { TIDS(); final_norm(ws, out, lane, gw, NGW); }
}

extern "C" void kernel_launch(void* const* d_in, const int* in_sizes, int n_in, void* d_out, int out_size, void* d_ws, size_t ws_size, hipStream_t stream) {
    static int grid = 0;
    if (grid == 0) {
        if (n_in != 21 || ws_size < WS_END) { fprintf(stderr, "kernel_launch: expected 21 inputs and >= %zu bytes of workspace (got %d, %zu)\n", (size_t)WS_END, n_in, ws_size); grid = -1; return; }
        int dev = 0, cus = 0, per_cu = 0;
        (void)hipGetDevice(&dev); (void)hipDeviceGetAttribute(&cus, hipDeviceAttributeMultiprocessorCount, dev);
        if (hipFuncSetAttribute((const void*)mega, hipFuncAttributeMaxDynamicSharedMemorySize, LDS_BYTES) != hipSuccess) fprintf(stderr, "kernel_launch: hipFuncSetAttribute failed\n");
        if (hipOccupancyMaxActiveBlocksPerMultiprocessor(&per_cu, (const void*)mega, NT, LDS_BYTES) != hipSuccess || per_cu < 1) { fprintf(stderr, "kernel_launch: occupancy query says %d\n", per_cu); per_cu = 1; }
        (void)hipGetLastError();
        grid = cus > 0 ? cus : 256;
    }
    if (grid < 0) return;
    Args a{};
    for (int i = 0; i < 21; ++i) a.in[i] = (const float*)d_in[i];
    a.out = (float*)d_out; a.ws = (unsigned char*)d_ws;
    void* args[] = {&a};
    hipError_t e = hipLaunchCooperativeKernel((const void*)mega, dim3(grid), dim3(NT), args, LDS_BYTES, stream);
    if (e != hipSuccess) fprintf(stderr, "kernel_launch: cooperative launch failed: %s (grid %d)\n", hipGetErrorString(e), grid);
}
```

```cpp
#include <hip/hip_runtime.h>
#include <hip/hip_cooperative_groups.h>
#include <cstdio>
#include <cstdint>
namespace cg = cooperative_groups;
namespace pg8 {
#define PG8_LAS __attribute__((address_space(3)))
typedef unsigned short bf16_t;
typedef short bf16x8 __attribute__((ext_vector_type(8)));
typedef float f32x4 __attribute__((ext_vector_type(4)));
typedef unsigned u32x4 __attribute__((ext_vector_type(4)));
constexpr int BM = 256, BK = 64, HALF = 128, HTB = HALF * BK * 2  , STAGE_BYTES = 8 * HTB, NXCD = 8, WGM = 8;

__host__ __device__ __forceinline__ int lds_byte(int r, int c) { const int st = (r >> 4) * 2 + (c >> 5), rr = r & 15, cc = c & 31, ob = rr * 64 + cc * 2; return st * 1024 + (ob ^ (((ob >> 9) & 1) << 5)); }
__host__ __device__ __forceinline__ void stage_rc(int b, int& R, int& C) { const int st = b / 1024, sb = b % 1024, swz = sb ^ (((sb >> 9) & 1) << 5); R = (st >> 1) * 16 + swz / 64; C = (st & 1) * 32 + (swz % 64) / 2; }
__host__ __device__ __forceinline__ int perm32(int rho) { const int n = rho >> 4, i = rho & 15; return 8 * (i >> 2) + 4 * n + (i & 3); }

struct Unit { int pm, pn, kt0, nkt, split; };
struct Gemm { const bf16_t* A; const bf16_t* Bt; int M, N, K; };

struct StaticOrder {
    int nM, nN, nwg, G, c, nkt;
    __host__ __device__ void init(int M, int N, int K, int G_, int c_) { nM = M / BM; nN = N / BM; nwg = nM * nN; G = G_; c = c_; nkt = K / BK; }
    __host__ __device__ bool next(int i, Unit& u) const {
        const long L = (long)i * G + c; if (L >= nwg) return false;
        int wgid = (int)L; { const int q = nwg / NXCD, r = nwg % NXCD, xcd = wgid % NXCD, off = wgid / NXCD; wgid = (xcd < r ? xcd * (q + 1) : r * (q + 1) + (xcd - r) * q) + off; }
        const int nig = WGM * nN, gid = wgid / nig, fm = gid * WGM, gsz = (nM - fm) < WGM ? (nM - fm) : WGM;
        u.pm = fm + ((wgid % nig) % gsz); u.pn = (wgid % nig) / gsz; u.kt0 = 0; u.nkt = nkt; u.split = 0; return true;
    }
    __device__ __forceinline__ void a_ready(const Unit&) const {}
    __device__ __forceinline__ void done(const Unit&) const {}
};

__device__ __forceinline__ unsigned cvt_pk_bf16(float lo, float hi) { unsigned r; asm volatile("v_cvt_pk_bf16_f32 %0, %1, %2" : "=v"(r) : "v"(lo), "v"(hi)); return r; }
typedef float f32x2 __attribute__((ext_vector_type(2)));
struct SplitOrder {
    StaticOrder lat; int nctx, S, G, c, nkt;
    __host__ __device__ void init(int M, int K, int S_, int G_, int c_) { lat.init(M < 16384 ? M : 16384, 1024, K, G_, c_); nctx = M > 16384 ? ((M - 16384) / BM) * 4 : 0; S = S_; G = G_; c = c_; nkt = K / BK; }
    __host__ __device__ __forceinline__ bool next(int i, Unit& u) const {
        const int L = i * G + c; const bool isLat = L < lat.nwg;
        Unit a; a.pm = 0; a.pn = 0; a.kt0 = 0; a.nkt = nkt; a.split = 0;
        const bool okLat = lat.next(i, a);
        const int idx = isLat ? 0 : L - lat.nwg; const int tile = idx / S, piece = idx - tile * S, pk = nkt / S;
        u.pm = isLat ? a.pm : 64 + (tile >> 2); u.pn = isLat ? a.pn : (tile & 3); u.nkt = isLat ? nkt : pk; u.kt0 = isLat ? 0 : piece * pk; u.split = isLat ? 0 : 1;
        return isLat ? okLat : (idx < nctx * S);
    }
    __device__ __forceinline__ void a_ready(const Unit&) const {}
    __device__ __forceinline__ void done(const Unit&) const {}
};
__device__ __forceinline__ float gelu_tanh_f(float x) {
    const float y = x * (0.7978845608f + 0.0356774081f * x * x);
    const float e = __builtin_amdgcn_exp2f(-2.885390082f * y);
    return x * __builtin_amdgcn_rcpf(1.0f + e);
}
template <int O> __device__ __forceinline__ float xshfl(float v) { static_assert(O < 32, "xshfl<O>: O < 32"); return __uint_as_float((unsigned)__builtin_amdgcn_ds_swizzle((int)__float_as_uint(v), (O << 10) | 0x1f)); }
__device__ __forceinline__ float xshfl32(float v, int lane) { return __uint_as_float((unsigned)__builtin_amdgcn_ds_bpermute((lane ^ 32) << 2, (int)__float_as_uint(v))); }
__device__ __forceinline__ float silu_f(float x) { return x * __builtin_amdgcn_rcpf(1.0f + __builtin_amdgcn_exp2f(-1.4426950409f * x)); }

struct EpiStoreBf16 {
    static constexpr bool PERM = true, AFTER_DRAIN = false;
    bf16_t* O; int ldc; int gelu_pn_lt; int scale_pn_lt; float scale0;
    __device__ __forceinline__ void operator()(const f32x4 (&acc)[2][2][4][2], const Unit& u, int wr, int wc, int fr, int fq) const {
        const int row0 = u.pm * BM + wr * 64 + fr; const int col0 = u.pn * BM + wc * 32 + 8 * fq;
        const bool act = u.pn < gelu_pn_lt; const float sc = (u.pn < scale_pn_lt) ? scale0 : 1.f;
#pragma unroll
        for (int ai = 0; ai < 2; ++ai)
#pragma unroll
            for (int m = 0; m < 4; ++m) { bf16_t* rowp = O + (size_t)(row0 + ai * HALF + m * 16) * ldc + col0;
#pragma unroll
                for (int bj = 0; bj < 2; ++bj) { f32x4 v0 = acc[ai][bj][m][0], v1 = acc[ai][bj][m][1];
                    if (act) {
#pragma unroll
                        for (int e = 0; e < 4; ++e) { v0[e] = gelu_tanh_f(v0[e]); v1[e] = gelu_tanh_f(v1[e]); } }
                    v0 = v0 * sc; v1 = v1 * sc; u32x4 w; w.x = cvt_pk_bf16(v0[0], v0[1]); w.y = cvt_pk_bf16(v0[2], v0[3]); w.z = cvt_pk_bf16(v1[0], v1[1]); w.w = cvt_pk_bf16(v1[2], v1[3]);
                    *(u32x4*)(rowp + bj * HALF) = w; } }
    }
};

struct EpiGVt {
    static constexpr bool PERM = true, AFTER_DRAIN = false;
    bf16_t* O; int ldc; float* stats;
    __device__ __forceinline__ void operator()(const f32x4 (&acc)[2][2][4][2], const Unit& u, int wr, int wc, int fr, int fq) const {
        const int row0 = u.pm * BM + wr * 64 + fr; const int col0 = u.pn * BM + wc * 32 + 8 * fq;
        const int slot = u.pm * 2 + wr;
#pragma unroll
        for (int bj = 0; bj < 2; ++bj) {
            float s[2][4], q[2][4];
#pragma unroll
            for (int n = 0; n < 2; ++n)
#pragma unroll
                for (int e = 0; e < 4; ++e) { s[n][e] = 0.f; q[n][e] = 0.f; }
#pragma unroll
            for (int ai = 0; ai < 2; ++ai)
#pragma unroll
                for (int m = 0; m < 4; ++m) { bf16_t* rowp = O + (size_t)(row0 + ai * HALF + m * 16) * ldc + col0;
                    f32x4 v0 = acc[ai][bj][m][0], v1 = acc[ai][bj][m][1];
#pragma unroll
                    for (int e = 0; e < 4; ++e) { v0[e] = gelu_tanh_f(v0[e]); v1[e] = gelu_tanh_f(v1[e]);
                        s[0][e] += v0[e]; q[0][e] += v0[e] * v0[e]; s[1][e] += v1[e]; q[1][e] += v1[e] * v1[e]; }
                    u32x4 w; w.x = cvt_pk_bf16(v0[0], v0[1]); w.y = cvt_pk_bf16(v0[2], v0[3]); w.z = cvt_pk_bf16(v1[0], v1[1]); w.w = cvt_pk_bf16(v1[2], v1[3]);
                    *(u32x4*)(rowp + bj * HALF) = w; }
#pragma unroll
            for (int n = 0; n < 2; ++n)
#pragma unroll
                for (int e = 0; e < 4; ++e) { float a = s[n][e], b = q[n][e];
                    a += xshfl<1>(a); b += xshfl<1>(b); a += xshfl<2>(a); b += xshfl<2>(b); a += xshfl<4>(a); b += xshfl<4>(b); a += xshfl<8>(a); b += xshfl<8>(b);
                    if (fr == 0) { float* p = stats + ((size_t)(col0 + bj * HALF + 4 * n + e) * 4 + slot) * 2; p[0] = a; p[1] = b; } }
            asm volatile("" ::: "memory");
        }
    }
};

struct EpiResGate {
    static constexpr bool PERM = false, AFTER_DRAIN = false;
    float* X; const float* gate_base; float* part;
    __device__ __forceinline__ void operator()(const f32x4 (&acc)[2][2][4][2], const Unit& u, int wr, int wc, int fr, int fq) const {
        const int col0 = u.pn * BM + wc * 32 + 4 * fq;
        if (u.split) {
            float* pb = part + ((size_t)(u.kt0 / u.nkt) * 1024 + (size_t)(u.pm - 64) * BM) * 1024 + col0;
#pragma unroll
            for (int ai = 0; ai < 2; ++ai)
#pragma unroll
                for (int m = 0; m < 4; ++m)
#pragma unroll
                    for (int bj = 0; bj < 2; ++bj)
#pragma unroll
                        for (int n = 0; n < 2; ++n) *(f32x4*)(pb + (size_t)(ai * HALF + wr * 64 + m * 16 + fr) * 1024 + bj * HALF + n * 16) = acc[ai][bj][m][n];
            return; }
        const int cond = u.pm < 64 ? (u.pm >> 4) : 4; const float* gate = gate_base + cond * 6144;
        f32x4 gv[2][2];
#pragma unroll
        for (int bj = 0; bj < 2; ++bj)
#pragma unroll
            for (int n = 0; n < 2; ++n) gv[bj][n] = *(const f32x4*)(gate + col0 + bj * HALF + n * 16);
#pragma unroll
        for (int ai = 0; ai < 2; ++ai)
#pragma unroll
            for (int m = 0; m < 4; ++m) { float* rowp = X + (size_t)(u.pm * BM + ai * HALF + wr * 64 + m * 16 + fr) * 1024 + col0;
#pragma unroll
                for (int bj = 0; bj < 2; ++bj)
#pragma unroll
                    for (int n = 0; n < 2; ++n) { float* p = rowp + bj * HALF + n * 16; const f32x4 v = gv[bj][n] * acc[ai][bj][m][n];
                        *(f32x4*)p = *(const f32x4*)p + v; } }
    }
};

struct EpiSwiGLU {
    static constexpr bool PERM = true, AFTER_DRAIN = false;
    bf16_t* O; int ldc;
    __device__ __forceinline__ void operator()(const f32x4 (&acc)[2][2][4][2], const Unit& u, int wr, int wc, int fr, int fq) const {
        const int row0 = u.pm * BM + wr * 64 + fr; const int col0 = u.pn * HALF + wc * 32 + 8 * fq;
#pragma unroll
        for (int ai = 0; ai < 2; ++ai)
#pragma unroll
            for (int m = 0; m < 4; ++m) { bf16_t* rowp = O + (size_t)(row0 + ai * HALF + m * 16) * ldc + col0;
                f32x4 v0, v1;
#pragma unroll
                for (int e = 0; e < 4; ++e) { v0[e] = silu_f(acc[ai][0][m][0][e]) * acc[ai][1][m][0][e]; v1[e] = silu_f(acc[ai][0][m][1][e]) * acc[ai][1][m][1][e]; }
                u32x4 w; w.x = cvt_pk_bf16(v0[0], v0[1]); w.y = cvt_pk_bf16(v0[2], v0[3]); w.z = cvt_pk_bf16(v1[0], v1[1]); w.w = cvt_pk_bf16(v1[2], v1[3]);
                *(u32x4*)rowp = w; }
    }
};

template <class Epi, class Sched, bool ALIGN_EPI = false, bool SP2 = false>
__device__ __forceinline__ void gemm_phase(PG8_LAS unsigned char* lds, const Gemm g, const Sched& S, const Epi& E) {
    int tid_l = threadIdx.x; asm volatile("" : "+v"(tid_l));
    const int tid = tid_l, wid = __builtin_amdgcn_readfirstlane(tid >> 6), lane = tid & 63, wr = wid >> 2, wc = wid & 3, fr = lane & 15, fq = lane >> 4;
    const int K = g.K;
    unsigned voffA[2], voffB[2];
#pragma unroll
    for (int i = 0; i < 2; ++i) { int R, C; stage_rc(tid * 16 + i * 8192, R, C); const int Rb = Epi::PERM ? ((R & ~31) + perm32(R & 31)) : R;
        voffA[i] = (unsigned)(R * K + C) * 2u; voffB[i] = (unsigned)(Rb * K + C) * 2u; }
    const size_t kstep = (size_t)(BK * 2);
    const size_t hstep = (size_t)HALF * K * 2;
    const size_t tstep = 2 * hstep;
    const unsigned ldsw = (unsigned)wid * 1024u;
    const int aoff = lds_byte(wr * 64 + fr, fq * 8), boff = lds_byte(wc * 32 + fr, fq * 8);
#define PG8_SA(b, h) (((b) * 2 + (h)) * HTB)
#define PG8_SB(b, h) ((4 + (b) * 2 + (h)) * HTB)
#define PG8_STAGE(bufoff, gbase, voff) do { _Pragma("unroll") for (int _i = 0; _i < 2; ++_i) \
        __builtin_amdgcn_global_load_lds((const unsigned*)((const char*)(gbase) + (voff)[_i]), (PG8_LAS unsigned*)(lds + (bufoff) + ldsw + _i * 8192), 16, 0, 0); } while (0)
#define PG8_LDA(dst, b, h) do { _Pragma("unroll") for (int m = 0; m < 4; ++m) _Pragma("unroll") for (int k = 0; k < 2; ++k) dst[m][k] = *(const PG8_LAS bf16x8*)(lds + PG8_SA(b, h) + aoff + m * 2048 + k * 1024); } while (0)
#define PG8_LDB(dst, b, h) do { _Pragma("unroll") for (int n = 0; n < 2; ++n) _Pragma("unroll") for (int k = 0; k < 2; ++k) dst[n][k] = *(const PG8_LAS bf16x8*)(lds + PG8_SB(b, h) + boff + n * 2048 + k * 1024); } while (0)
#define PG8_MMA(ai, bj, At, Bt) do { __builtin_amdgcn_s_setprio(1); _Pragma("unroll") for (int m = 0; m < 4; ++m) _Pragma("unroll") for (int n = 0; n < 2; ++n) _Pragma("unroll") for (int k = 0; k < 2; ++k) \
        acc[ai][bj][m][n] = __builtin_amdgcn_mfma_f32_16x16x32_bf16(Bt[n][k], At[m][k], acc[ai][bj][m][n], 0, 0, 0); __builtin_amdgcn_s_setprio(0); } while (0)
#define PG8_WAIT_V(n) asm volatile("s_waitcnt vmcnt(" #n ")" ::: "memory")
#define PG8_WAIT_L(n) asm volatile("s_waitcnt lgkmcnt(" #n ")" ::: "memory")
#define PG8_BAR __builtin_amdgcn_s_barrier()
#define PG8_SCHED __builtin_amdgcn_sched_barrier(0)
    Unit cur, nxt; int ui = 0;
    if (!S.next(0, cur)) return;
    f32x4 acc[2][2][4][2];
#pragma unroll
    for (int a = 0; a < 2; ++a)
#pragma unroll
        for (int b = 0; b < 2; ++b)
#pragma unroll
            for (int m = 0; m < 4; ++m)
#pragma unroll
                for (int n = 0; n < 2; ++n) acc[a][b][m][n] = (f32x4){0.f, 0.f, 0.f, 0.f};
    bf16x8 At[4][2], B0[2][2], B1[2][2];
    const char* cA = (const char*)g.A + (size_t)cur.pm * tstep + (size_t)cur.kt0 * kstep; const char* cB = (const char*)g.Bt + (size_t)cur.pn * tstep + (size_t)cur.kt0 * kstep;
    S.a_ready(cur);
    if constexpr (SP2) {
        PG8_STAGE(PG8_SB(0, 0), cB, voffB); PG8_STAGE(PG8_SB(0, 1), cB + hstep, voffB); PG8_STAGE(PG8_SA(0, 0), cA, voffA); PG8_STAGE(PG8_SA(0, 1), cA + hstep, voffA);
        if (wr == 1) PG8_BAR;
        PG8_WAIT_V(2); PG8_BAR;
        PG8_STAGE(PG8_SB(1, 0), cB + kstep, voffB); PG8_STAGE(PG8_SA(1, 0), cA + kstep, voffA); PG8_STAGE(PG8_SB(1, 1), cB + hstep + kstep, voffB);
        PG8_WAIT_V(6); PG8_BAR;
    } else {
        PG8_STAGE(PG8_SB(0, 0), cB, voffB); PG8_STAGE(PG8_SA(0, 0), cA, voffA); PG8_STAGE(PG8_SB(0, 1), cB + hstep, voffB); PG8_STAGE(PG8_SA(0, 1), cA + hstep, voffA);
        if (wr == 1) PG8_BAR;
        PG8_WAIT_V(4); PG8_BAR;
        PG8_STAGE(PG8_SB(1, 0), cB + kstep, voffB); PG8_STAGE(PG8_SA(1, 0), cA + kstep, voffA); PG8_STAGE(PG8_SB(1, 1), cB + hstep + kstep, voffB);
        PG8_WAIT_V(6); PG8_BAR;
    }
    for (;;) {
        const bool has_next = S.next(ui + 1, nxt);
        const char* nA = has_next ? (const char*)g.A + (size_t)nxt.pm * tstep + (size_t)nxt.kt0 * kstep : cA; const char* nB = has_next ? (const char*)g.Bt + (size_t)nxt.pn * tstep + (size_t)nxt.kt0 * kstep : cB;
        const int nt = cur.nkt;
        for (int t = 0; t < nt; t += 2) {
            const bool last = (t == nt - 2);
            const char* a1 = cA + (size_t)(t + 1) * kstep;
            const char* a2 = last ? nA : cA + (size_t)(t + 2) * kstep; const char* b2 = last ? nB : cB + (size_t)(t + 2) * kstep;
            const char* a3 = a2 + kstep; const char* b3 = b2 + kstep;
            if (last && has_next) S.a_ready(nxt);
            if constexpr (SP2) {
            PG8_LDB(B0, 0, 0); PG8_LDB(B1, 0, 1); PG8_SCHED; PG8_LDA(At, 0, 0); PG8_STAGE(PG8_SA(1, 1), a1 + hstep, voffA);
            PG8_WAIT_V(8); PG8_WAIT_L(0); PG8_BAR; PG8_MMA(0, 0, At, B0); PG8_MMA(0, 1, At, B1); PG8_BAR; PG8_SCHED;
            PG8_LDA(At, 0, 1); PG8_STAGE(PG8_SB(0, 0), b2, voffB); PG8_STAGE(PG8_SB(0, 1), b2 + hstep, voffB); PG8_STAGE(PG8_SA(0, 0), a2, voffA);
            PG8_WAIT_V(8); PG8_WAIT_L(0); PG8_BAR; PG8_MMA(1, 0, At, B0); PG8_MMA(1, 1, At, B1); PG8_BAR; PG8_SCHED;
            PG8_LDB(B0, 1, 0); PG8_LDB(B1, 1, 1); PG8_SCHED; PG8_LDA(At, 1, 0); PG8_STAGE(PG8_SA(0, 1), a2 + hstep, voffA);
            PG8_WAIT_V(8); PG8_WAIT_L(0); PG8_BAR; PG8_MMA(0, 0, At, B0); PG8_MMA(0, 1, At, B1); PG8_BAR; PG8_SCHED;
            PG8_LDA(At, 1, 1); PG8_STAGE(PG8_SB(1, 0), b3, voffB); PG8_STAGE(PG8_SB(1, 1), b3 + hstep, voffB); PG8_STAGE(PG8_SA(1, 0), a3, voffA);
            PG8_WAIT_V(8); PG8_WAIT_L(0); PG8_BAR; PG8_MMA(1, 0, At, B0); PG8_MMA(1, 1, At, B1); PG8_BAR; PG8_SCHED;
            } else {
            PG8_LDB(B0, 0, 0); PG8_SCHED; PG8_LDA(At, 0, 0); PG8_STAGE(PG8_SA(1, 1), a1 + hstep, voffA);
            PG8_WAIT_L(8); PG8_BAR; PG8_WAIT_L(0); PG8_MMA(0, 0, At, B0); PG8_BAR; PG8_SCHED;
            PG8_LDB(B1, 0, 1); PG8_STAGE(PG8_SB(0, 0), b2, voffB);
            PG8_BAR; PG8_WAIT_L(0); PG8_MMA(0, 1, At, B1); PG8_BAR;
            PG8_LDA(At, 0, 1); PG8_STAGE(PG8_SA(0, 0), a2, voffA);
            PG8_BAR; PG8_WAIT_L(0); PG8_MMA(1, 0, At, B0); PG8_BAR; PG8_SCHED;
            PG8_STAGE(PG8_SB(0, 1), b2 + hstep, voffB);
            PG8_WAIT_V(6); PG8_BAR; PG8_MMA(1, 1, At, B1); PG8_BAR;
            PG8_LDB(B0, 1, 0); PG8_SCHED; PG8_LDA(At, 1, 0); PG8_STAGE(PG8_SA(0, 1), a2 + hstep, voffA);
            PG8_WAIT_L(8); PG8_BAR; PG8_WAIT_L(0); PG8_MMA(0, 0, At, B0); PG8_BAR; PG8_SCHED;
            PG8_LDB(B1, 1, 1); PG8_STAGE(PG8_SB(1, 0), b3, voffB);
            PG8_BAR; PG8_WAIT_L(0); PG8_MMA(0, 1, At, B1); PG8_BAR;
            PG8_LDA(At, 1, 1); PG8_STAGE(PG8_SA(1, 0), a3, voffA);
            PG8_BAR; PG8_WAIT_L(0); PG8_MMA(1, 0, At, B0); PG8_BAR; PG8_SCHED;
            PG8_STAGE(PG8_SB(1, 1), b3 + hstep, voffB);
            PG8_WAIT_V(6); PG8_BAR; PG8_MMA(1, 1, At, B1); PG8_BAR;
            }
        }
        if constexpr (ALIGN_EPI) { if (wr == 0) PG8_BAR; }
        if constexpr (!Epi::AFTER_DRAIN) { E(acc, cur, wr, wc, fr, fq); S.done(cur); }
        if (!has_next) break;
#pragma unroll
        for (int a = 0; a < 2; ++a)
#pragma unroll
            for (int b = 0; b < 2; ++b)
#pragma unroll
                for (int m = 0; m < 4; ++m)
#pragma unroll
                    for (int n = 0; n < 2; ++n) acc[a][b][m][n] = (f32x4){0.f, 0.f, 0.f, 0.f};
        cur = nxt; cA = nA; cB = nB; ++ui;
        if constexpr (ALIGN_EPI) { if (wr == 1) PG8_BAR; }
    }
    PG8_WAIT_V(0);
    if constexpr (!ALIGN_EPI) { if (wr == 0) PG8_BAR; }
    PG8_BAR;
    if constexpr (Epi::AFTER_DRAIN) { E.fused(acc, cur, wr, wc, fr, fq, lds, wid, lane); S.done(cur); }
#undef PG8_SA
#undef PG8_SB
#undef PG8_STAGE
#undef PG8_LDA
#undef PG8_LDB
#undef PG8_MMA
#undef PG8_WAIT_V
#undef PG8_WAIT_L
#undef PG8_BAR
#undef PG8_SCHED
}
}
#define LAS __attribute__((address_space(3)))
typedef unsigned short bf16;
typedef unsigned v4u __attribute__((ext_vector_type(4)));
typedef unsigned v2u __attribute__((ext_vector_type(2)));
typedef float f32x4 __attribute__((ext_vector_type(4)));
typedef short bf16x8 __attribute__((ext_vector_type(8)));

constexpr int NWAVES = 8, NT = 512;
constexpr int D = 1024, ML = 16384, MC = 1024, MA = ML + MC, SEQ = 4096, CTXL = 256, DFF = 2816, NFI = 2 * DFF;
constexpr float EPS = 1e-6f, LOG2E = 1.4426950408889634f;
constexpr size_t MiB = 1u << 20;
constexpr size_t WS_MOD = 1 * MiB;
constexpr size_t WS_STATS = 2 * MiB;
constexpr size_t WS_WS = 3 * MiB;
constexpr size_t WS_PRM = 3 * MiB + 512 * 1024;
constexpr int PRM_NMIX = 0, PRM_NFFN = 4096, PRM_LNV = 8192, PRM_BS = 9216, PRM_RPB = 10240, PRM_NFIN = 10240 + 14880, PRM_TOTAL = PRM_NFIN + 1024;
constexpr size_t WS_XW = 4 * MiB;
constexpr size_t WS_HN = 72 * MiB;
constexpr size_t WS_SCR = 106 * MiB;
constexpr size_t WS_H2 = WS_SCR;
constexpr size_t WS_QK = WS_SCR, WS_VT = WS_SCR + 68 * MiB, WS_O = WS_SCR + 102 * MiB;
constexpr size_t WS_UQ = WS_SCR, WS_GVT = WS_SCR + 34 * MiB, WS_Y = WS_SCR + 51 * MiB;
constexpr size_t WS_WIN = 242 * MiB;
constexpr size_t WS_WOAB = 248 * MiB;
constexpr size_t WS_WQKV = 252 * MiB;
constexpr size_t WS_WONA = 264 * MiB;
constexpr size_t WS_WFI = 268 * MiB;
constexpr size_t WS_WFO = 312 * MiB;
constexpr size_t WS_PART = 334 * MiB;
constexpr size_t WS_END = 378 * MiB;
constexpr int LDS_BYTES = 147456;

struct Args { const float* in[21]; float* out; unsigned char* ws; };

__device__ __forceinline__ float bf2f(unsigned b) { return __uint_as_float(b << 16); }
__device__ __forceinline__ unsigned pk2(float lo, float hi) { return pg8::cvt_pk_bf16(lo, hi); }
__device__ __forceinline__ float wave_sum(float v, int lane) {
    v += pg8::xshfl<1>(v); v += pg8::xshfl<2>(v); v += pg8::xshfl<4>(v); v += pg8::xshfl<8>(v); v += pg8::xshfl<16>(v); v += pg8::xshfl32(v, lane);
    return v;
}
#define LDS_WAIT() asm volatile("s_waitcnt lgkmcnt(0)" ::: "memory")

__device__ __forceinline__ void transpose_item(const float* W, int ldw, bf16* WT, int K, int k0, int n0, int drow0, LAS float* scr, int lane) {
#pragma unroll 8
    for (int i = 0; i < 32; ++i) { const int kk = 2 * i + (lane >> 5); scr[kk * 33 + (lane & 31)] = W[(size_t)(k0 + kk) * ldw + n0 + (lane & 31)]; }
    LDS_WAIT();
    const int c = lane & 7;
#pragma unroll
    for (int j = 0; j < 4; ++j) { const int n = (lane >> 3) + 8 * j; const LAS float* s = scr + (8 * c) * 33 + n;
        v4u o; o.x = pk2(s[0 * 33], s[1 * 33]); o.y = pk2(s[2 * 33], s[3 * 33]); o.z = pk2(s[4 * 33], s[5 * 33]); o.w = pk2(s[6 * 33], s[7 * 33]);
        *(v4u*)(WT + (size_t)(drow0 + n) * K + k0 + 8 * c) = o; }
    LDS_WAIT();
}

__device__ __forceinline__ void prologue(const Args& a, LAS unsigned char* lds, int tid, int lane, int wave, int bid, int G, int gw, int NGW) {
    unsigned char* ws = a.ws;
    {
        LAS float* scr = (LAS float*)(lds + wave * 16384);
        constexpr int I_IN = 16 * 32, I_SQ = 16 * 32, I_QKV = 16 * 96, I_FI = 16 * 176, I_FO = 44 * 32;
        constexpr int NITEMS = 2 * I_IN + 2 * I_SQ + 2 * I_QKV + 2 * I_SQ + 4 * I_FI + 4 * I_FO;
        for (int it = gw; it < NITEMS; it += NGW) {
            int r = it;
            if (r < 2 * I_IN) { const int j = r / I_IN; r -= j * I_IN; const int kb = r / 32, nb = r % 32, n0 = nb * 32;
                transpose_item(a.in[8] + (size_t)j * 1024 * 1536, 1536, (bf16*)(ws + WS_WIN) + (size_t)j * 1536 * 1024, 1024, kb * 64, n0, n0 < 512 ? n0 : n0 + 512, scr, lane); continue; } r -= 2 * I_IN;
            if (r < 2 * I_SQ) { const int j = r / I_SQ; r -= j * I_SQ; const int kb = r / 32, nb = r % 32;
                transpose_item(a.in[14] + (size_t)j * 1024 * 1024, 1024, (bf16*)(ws + WS_WOAB) + (size_t)j * 1024 * 1024, 1024, kb * 64, nb * 32, nb * 32, scr, lane); continue; } r -= 2 * I_SQ;
            if (r < 2 * I_QKV) { const int j = r / I_QKV; r -= j * I_QKV; const int kb = r / 96, nb = r % 96;
                transpose_item(a.in[15] + (size_t)j * 1024 * 3072, 3072, (bf16*)(ws + WS_WQKV) + (size_t)j * 3072 * 1024, 1024, kb * 64, nb * 32, nb * 32, scr, lane); continue; } r -= 2 * I_QKV;
            if (r < 2 * I_SQ) { const int j = r / I_SQ; r -= j * I_SQ; const int kb = r / 32, nb = r % 32;
                transpose_item(a.in[17] + (size_t)j * 1024 * 1024, 1024, (bf16*)(ws + WS_WONA) + (size_t)j * 1024 * 1024, 1024, kb * 64, nb * 32, nb * 32, scr, lane); continue; } r -= 2 * I_SQ;
            if (r < 4 * I_FI) { const int i = r / I_FI; r -= i * I_FI; const int kb = r / 176, nb = r % 176, n0 = nb * 32;
                const int jj = n0 < DFF ? n0 : n0 - DFF; const int drow0 = (jj >> 7) * 256 + (n0 < DFF ? 0 : 128) + (jj & 127);
                transpose_item(a.in[18] + (size_t)i * 1024 * NFI, NFI, (bf16*)(ws + WS_WFI) + (size_t)i * NFI * 1024, 1024, kb * 64, n0, drow0, scr, lane); continue; } r -= 4 * I_FI;
            { const int i = r / I_FO; r -= i * I_FO; const int kb = r / 32, nb = r % 32;
                transpose_item(a.in[19] + (size_t)i * DFF * 1024, 1024, (bf16*)(ws + WS_WFO) + (size_t)i * 1024 * DFF, DFF, kb * 64, nb * 32, nb * 32, scr, lane); }
        }
    }
    for (int e = bid * NT + tid; e < 2 * 4 * 128 * 128 / 2; e += G * NT) { const float2 v = *(const float2*)(a.in[10] + 2 * (size_t)e); ((unsigned*)(ws + WS_WS))[e] = pk2(v.x, v.y); }
    {
        float* prm = (float*)(ws + WS_PRM);
        for (int e = bid * NT + tid; e < PRM_TOTAL; e += G * NT) {
            float v;
            if (e < PRM_NFFN) v = a.in[6][e]; else if (e < PRM_LNV) v = a.in[7][e - PRM_NFFN]; else if (e < PRM_BS) v = a.in[9][e - PRM_LNV];
            else if (e < PRM_RPB) v = a.in[11][e - PRM_BS]; else if (e < PRM_NFIN) v = a.in[16][e - PRM_RPB] * LOG2E; else v = a.in[20][e - PRM_NFIN];
            prm[e] = v; }
        f32x4* xw = (f32x4*)(ws + WS_XW);
        for (int e = bid * NT + tid; e < MA * 256; e += G * NT) xw[e] = e < ML * 256 ? ((const f32x4*)a.in[0])[e] : ((const f32x4*)a.in[2])[e - ML * 256];
    }
    __syncthreads();
    for (int it = bid; it < 128; it += G) {
        const int j = it >> 6, g = (it >> 4) & 3, kb = it & 15, k0 = kb * 64;
        LAS float* wp = (LAS float*)lds; LAS float* wi = (LAS float*)(lds + 65536);
        const float* wpool = a.in[12] + (size_t)(j * 4 + g) * 16384;
#pragma unroll 4
        for (int i = 0; i < 32; ++i) wp[tid + 512 * i] = wpool[tid + 512 * i];
        const float* win = a.in[8] + (size_t)j * 1024 * 1536 + 1024 + g * 128;
#pragma unroll 4
        for (int i = 0; i < 16; ++i) { const int kk = (tid >> 7) + 4 * i, c = tid & 127; wi[kk * 129 + c] = win[(size_t)(k0 + kk) * 1536 + c]; }
        __syncthreads();
        const int kk = tid & 63, d0 = (tid >> 6) * 16;
        float acc[16];
#pragma unroll
        for (int i = 0; i < 16; ++i) acc[i] = 0.f;
        for (int c = 0; c < 128; ++c) { const float av = wi[kk * 129 + c];
#pragma unroll
            for (int i = 0; i < 16; ++i) acc[i] += av * wp[c * 128 + d0 + i]; }
        const float* ps = a.in[13] + j * 512 + g * 128 + d0;
        bf16* out = (bf16*)(ws + WS_WIN) + (size_t)j * 1536 * 1024 + (size_t)(512 + g * 128 + d0) * 1024 + k0 + kk;
#pragma unroll
        for (int i = 0; i < 16; ++i) out[(size_t)i * 1024] = (bf16)(pk2(acc[i] * ps[i], 0.f) & 0xffffu);
        __syncthreads();
    }
    {
        LAS float* sv = (LAS float*)lds;
        LAS float* red = (LAS float*)(lds + 20480);
        for (int e = tid; e < 5 * 1024; e += NT) { const float v = e < 4096 ? a.in[1][e] : a.in[3][e - 4096]; sv[e] = pg8::silu_f(v); }
        __syncthreads();
        for (int it = bid; it < 4 * 192; it += G) {
            const int layer = it / 192, n0 = (it % 192) * 32, col = tid & 31, ks = tid >> 5;
            const float* wm = a.in[4] + ((size_t)layer * 1024 + ks * 64) * 6144 + n0 + col;
            float acc[5] = {0.f, 0.f, 0.f, 0.f, 0.f};
#pragma unroll 8
            for (int k = 0; k < 64; ++k) { const float w = wm[(size_t)k * 6144];
#pragma unroll
                for (int c = 0; c < 5; ++c) acc[c] += sv[c * 1024 + ks * 64 + k] * w; }
#pragma unroll
            for (int c = 0; c < 5; ++c) red[(ks * 5 + c) * 32 + col] = acc[c];
            __syncthreads();
            if (tid < 160) { const int c = tid >> 5; float s = a.in[5][layer * 6144 + n0 + col];
#pragma unroll
                for (int q = 0; q < 16; ++q) s += red[(q * 5 + c) * 32 + col];
                ((float*)(ws + WS_MOD))[(size_t)(layer * 5 + c) * 6144 + n0 + col] = s; }
            __syncthreads();
        }
    }
}

__device__ __forceinline__ void rowpass(unsigned char* ws, int layer, int which, int Mrows, int nparts, const float* gate4, int lane, int gw, int NGW) {
    float* XW = (float*)(ws + WS_XW); bf16* HN = (bf16*)(ws + WS_HN);
    const float* gn = (const float*)(ws + WS_PRM) + (which ? PRM_NFFN : PRM_NMIX) + layer * 1024;
    const float* mod = (const float*)(ws + WS_MOD) + (size_t)layer * 5 * 6144 + (which ? 3 : 0) * 1024;
    f32x4 g4[4];
#pragma unroll
    for (int j = 0; j < 4; ++j) g4[j] = *(const f32x4*)(gn + 4 * lane + 256 * j);
    for (int m = gw; m < Mrows; m += NGW) {
        const float* src = XW + (size_t)m * D;
        const int cond = m < ML ? (m >> 12) : 4;
        const float* sh = mod + cond * 6144; const float* sc = sh + 1024;
        f32x4 v[4]; float s = 0.f;
#pragma unroll
        for (int j = 0; j < 4; ++j) v[j] = *(const f32x4*)(src + 4 * lane + 256 * j);
        if (m >= ML && nparts > 0) {
            const float* pp = (const float*)(ws + WS_PART) + (size_t)(m - ML) * 1024 + 4 * lane;
            f32x4 a4[4];
#pragma unroll
            for (int j = 0; j < 4; ++j) a4[j] = (f32x4){0.f, 0.f, 0.f, 0.f};
            for (int p = 0; p < nparts; ++p)
#pragma unroll
                for (int j = 0; j < 4; ++j) a4[j] += *(const f32x4*)(pp + (size_t)p * 1024 * 1024 + 256 * j);
#pragma unroll
            for (int j = 0; j < 4; ++j) { v[j] += *(const f32x4*)(gate4 + 4 * lane + 256 * j) * a4[j]; *(f32x4*)(XW + (size_t)m * D + 4 * lane + 256 * j) = v[j]; }
        }
#pragma unroll
        for (int j = 0; j < 4; ++j) s += (v[j].x * v[j].x + v[j].y * v[j].y) + (v[j].z * v[j].z + v[j].w * v[j].w);
        const float rstd = 1.0f / sqrtf(wave_sum(s, lane) * (1.f / D) + EPS);
#pragma unroll
        for (int j = 0; j < 4; ++j) {
            const f32x4 s4 = *(const f32x4*)(sc + 4 * lane + 256 * j), h4 = *(const f32x4*)(sh + 4 * lane + 256 * j);
            const f32x4 o = (v[j] * rstd) * g4[j] * (s4 + 1.0f) + h4;
            v2u w; w.x = pk2(o.x, o.y); w.y = pk2(o.z, o.w);
            *(v2u*)(HN + (size_t)m * D + 4 * lane + 256 * j) = w; }
    }
}

__device__ __forceinline__ void final_norm(unsigned char* ws, float* out, int lane, int gw, int NGW) {
    const float* XW = (const float*)(ws + WS_XW); const float* gn = (const float*)(ws + WS_PRM) + PRM_NFIN;
    f32x4 g4[4];
#pragma unroll
    for (int j = 0; j < 4; ++j) g4[j] = *(const f32x4*)(gn + 4 * lane + 256 * j);
    for (int m = gw; m < ML; m += NGW) {
        f32x4 v[4]; float s = 0.f;
#pragma unroll
        for (int j = 0; j < 4; ++j) { v[j] = *(const f32x4*)(XW + (size_t)m * D + 4 * lane + 256 * j); s += (v[j].x * v[j].x + v[j].y * v[j].y) + (v[j].z * v[j].z + v[j].w * v[j].w); }
        const float rstd = 1.0f / sqrtf(wave_sum(s, lane) * (1.f / D) + EPS);
#pragma unroll
        for (int j = 0; j < 4; ++j) *(f32x4*)(out + (size_t)m * D + 4 * lane + 256 * j) = (v[j] * rstd) * g4[j];
    }
}

__device__ __forceinline__ void mix_phase(unsigned char* ws, LAS unsigned char* lds, int j, int tid, int lane, int wave, int bid, int G) {
    const float* prm = (const float*)(ws + WS_PRM);
    const bf16* UQ = (const bf16*)(ws + WS_UQ); const bf16* GVT = (const bf16*)(ws + WS_GVT); bf16* Y = (bf16*)(ws + WS_Y);
    const float* stats = (const float*)(ws + WS_STATS); const bf16* WSb = (const bf16*)(ws + WS_WS);
    LAS float* st = (LAS float*)lds;
    const int li = lane & 15, gq = lane >> 4;
    for (int u = bid; u < 136 * 4; u += G) {
        const int chunk = u >> 2, g = u & 3, token0 = chunk * 128;
        int s0, L, seqbase;
        if (chunk < 128) { s0 = (chunk & 31) * 128; L = SEQ; seqbase = (chunk >> 5) * SEQ; } else { const int cc = chunk - 128; s0 = (cc & 1) * 128; L = CTXL; seqbase = ML + (cc >> 1) * CTXL; }
        __syncthreads();
        if (tid < 128) { const float* p = stats + (size_t)(token0 + tid) * 8; const f32x4 p0 = *(const f32x4*)p, p1 = *(const f32x4*)(p + 4);
            const float S = (p0.x + p0.z) + (p1.x + p1.z), Q = (p0.y + p0.w) + (p1.y + p1.w);
            const float mean = S * (1.f / 512.f); const float var = fmaxf(Q * (1.f / 512.f) - mean * mean, 0.f);
            st[2 * tid] = mean; st[2 * tid + 1] = 1.0f / sqrtf(var + EPS); }
        __syncthreads();
        {
            const int c = 16 * wave + li;
            const float lnv = prm[PRM_LNV + j * 512 + g * 128 + c];
            f32x4 acc[8];
#pragma unroll
            for (int ib = 0; ib < 8; ++ib) acc[ib] = (f32x4){0.f, 0.f, 0.f, 0.f};
#pragma unroll
            for (int ks = 0; ks < 4; ++ks) {
                const v4u raw = *(const v4u*)(GVT + (size_t)(g * 128 + c) * MA + token0 + 32 * ks + 8 * gq);
                const LAS f32x4* sp = (const LAS f32x4*)(st + 2 * (32 * ks + 8 * gq));
                const f32x4 m0 = sp[0], m1 = sp[1], m2 = sp[2], m3 = sp[3];
                v4u an;
                an.x = pk2((bf2f(raw.x & 0xffffu) - m0.x) * m0.y * lnv, (bf2f(raw.x >> 16) - m0.z) * m0.w * lnv);
                an.y = pk2((bf2f(raw.y & 0xffffu) - m1.x) * m1.y * lnv, (bf2f(raw.y >> 16) - m1.z) * m1.w * lnv);
                an.z = pk2((bf2f(raw.z & 0xffffu) - m2.x) * m2.y * lnv, (bf2f(raw.z >> 16) - m2.z) * m2.w * lnv);
                an.w = pk2((bf2f(raw.w & 0xffffu) - m3.x) * m3.y * lnv, (bf2f(raw.w >> 16) - m3.z) * m3.w * lnv);
                const bf16x8 af = __builtin_bit_cast(bf16x8, an);
#pragma unroll
                for (int ib = 0; ib < 8; ++ib) {
                    const bf16x8 bfr = *(const bf16x8*)(WSb + ((size_t)((j * 4 + g) * 128 + 16 * ib + li)) * 128 + 32 * ks + 8 * gq);
                    acc[ib] = __builtin_amdgcn_mfma_f32_16x16x32_bf16(af, bfr, acc[ib], 0, 0, 0); }
            }
            const int cc = g * 128 + 16 * wave + 4 * gq;
#pragma unroll
            for (int ib = 0; ib < 8; ++ib) {
                const int tok = token0 + 16 * ib + li;
                const float bs = prm[PRM_BS + (j * 4 + g) * 128 + 16 * ib + li];
                const v2u uu = *(const v2u*)(UQ + (size_t)tok * 1024 + cc);
                v2u o; o.x = pk2(bf2f(uu.x & 0xffffu) * (acc[ib][0] + bs), bf2f(uu.x >> 16) * (acc[ib][1] + bs));
                o.y = pk2(bf2f(uu.y & 0xffffu) * (acc[ib][2] + bs), bf2f(uu.y >> 16) * (acc[ib][3] + bs));
                *(v2u*)(Y + (size_t)tok * 1024 + cc) = o; }
        }
        {
            const int c8 = tid & 15, rg = tid >> 4, hw = 1 << g;
            const int t0 = s0 + 4 * rg;
            const int rlo = max(t0 - hw, 0), rhi = min(t0 + 3 + hw, L);
            float sum[4][8], self[4][8];
#pragma unroll
            for (int tt = 0; tt < 4; ++tt)
#pragma unroll
                for (int e = 0; e < 8; ++e) { sum[tt][e] = 0.f; self[tt][e] = 0.f; }
            const bf16* qb = UQ + (size_t)seqbase * 1024 + 512 + g * 128 + c8 * 8;
            for (int r = rlo; r < rhi; ++r) {
                const v4u raw = *(const v4u*)(qb + (size_t)r * 1024);
                float f[8]; f[0] = bf2f(raw.x & 0xffffu); f[1] = bf2f(raw.x >> 16); f[2] = bf2f(raw.y & 0xffffu); f[3] = bf2f(raw.y >> 16);
                f[4] = bf2f(raw.z & 0xffffu); f[5] = bf2f(raw.z >> 16); f[6] = bf2f(raw.w & 0xffffu); f[7] = bf2f(raw.w >> 16);
#pragma unroll
                for (int tt = 0; tt < 4; ++tt) { const int t = t0 + tt; const bool in = (r >= t - hw) && (r < t + hw); const bool me = (r == t);
#pragma unroll
                    for (int e = 0; e < 8; ++e) { sum[tt][e] += in ? f[e] : 0.f; self[tt][e] = me ? f[e] : self[tt][e]; } }
            }
#pragma unroll
            for (int tt = 0; tt < 4; ++tt) { const int t = t0 + tt; const int lo = max(t - hw, 0), hi = min(t + hw, L); const float inv = 1.0f / (float)(hi - lo);
                v4u o; o.x = pk2(sum[tt][0] * inv - self[tt][0], sum[tt][1] * inv - self[tt][1]); o.y = pk2(sum[tt][2] * inv - self[tt][2], sum[tt][3] * inv - self[tt][3]);
                o.z = pk2(sum[tt][4] * inv - self[tt][4], sum[tt][5] * inv - self[tt][5]); o.w = pk2(sum[tt][6] * inv - self[tt][6], sum[tt][7] * inv - self[tt][7]);
                *(v4u*)(Y + (size_t)(seqbase + t) * 1024 + 512 + g * 128 + c8 * 8) = o; }
        }
    }
}

constexpr int ATT_RPB = 0, ATT_CK = 4096, ATT_CKP = 144, ATT_CV = 40960, ATT_CVP = 528;
template <bool CTXQ>
__device__ __forceinline__ void attn_wave(const bf16* QK, const bf16* VT, bf16* O, LAS unsigned char* lds, int b, int h, int r, int jg, int qtok0, int lane) {
    const int li = lane & 15, gq = lane >> 4;
    constexpr int NCH = CTXQ ? 8 : 16, NNB = CTXQ ? 0 : 8;
    const LAS float* rpbL = (const LAS float*)(lds + ATT_RPB);
    bf16x8 qf[2];
    { const bf16* qp = QK + (size_t)(qtok0 + li) * 2048 + h * 64 + 8 * gq; qf[0] = *(const bf16x8*)qp; qf[1] = *(const bf16x8*)(qp + 32); }
    const int kwin0 = jg == 0 ? 0 : (jg == 1 ? 8 : (jg == 2 ? 24 : 32));
    const int rs = min(max(r - 4, 0), 56);
    const int kofs = (li >> 2) * 8 + (li & 3);
    const int nbbase = b * SEQ + rs * 64 + kwin0;
    const bf16* kg = QK + (size_t)(nbbase + kofs) * 2048 + 1024 + h * 64 + 8 * gq;
    const LAS unsigned char* kl = lds + ATT_CK + kofs * ATT_CKP + gq * 16;
    f32x4 s[NCH][2];
#define ATT_QK_CTX(cc) do { _Pragma("unroll") for (int t = 0; t < 2; ++t) { \
        const bf16x8 k0 = *(const LAS bf16x8*)(kl + ((cc) * 32 + 4 * t) * ATT_CKP), k1 = *(const LAS bf16x8*)(kl + ((cc) * 32 + 4 * t) * ATT_CKP + 64); \
        f32x4 c = (f32x4){0.f, 0.f, 0.f, 0.f}; c = __builtin_amdgcn_mfma_f32_16x16x32_bf16(k0, qf[0], c, 0, 0, 0); c = __builtin_amdgcn_mfma_f32_16x16x32_bf16(k1, qf[1], c, 0, 0, 0); s[NNB + (cc)][t] = c; } } while (0)
    if constexpr (!CTXQ) {
        bf16x8 kb[2][8];
#define ATT_LOADK(buf, p) do { _Pragma("unroll") for (int c2 = 0; c2 < 2; ++c2) _Pragma("unroll") for (int t = 0; t < 2; ++t) _Pragma("unroll") for (int ks = 0; ks < 2; ++ks) \
        kb[buf][c2 * 4 + t * 2 + ks] = *(const bf16x8*)(kg + (size_t)((2 * (p) + c2) * 64 + 4 * t) * 2048 + ks * 32); __builtin_amdgcn_sched_barrier(0); } while (0)
#define ATT_QK_NB(buf, p) do { _Pragma("unroll") for (int c2 = 0; c2 < 2; ++c2) _Pragma("unroll") for (int t = 0; t < 2; ++t) { \
        f32x4 c = (f32x4){0.f, 0.f, 0.f, 0.f}; c = __builtin_amdgcn_mfma_f32_16x16x32_bf16(kb[buf][c2 * 4 + t * 2], qf[0], c, 0, 0, 0); \
        c = __builtin_amdgcn_mfma_f32_16x16x32_bf16(kb[buf][c2 * 4 + t * 2 + 1], qf[1], c, 0, 0, 0); s[2 * (p) + c2][t] = c; } __builtin_amdgcn_sched_barrier(0); } while (0)
        ATT_LOADK(0, 0); ATT_QK_CTX(0); ATT_QK_CTX(1);
        ATT_LOADK(1, 1); ATT_QK_NB(0, 0); ATT_QK_CTX(2); ATT_QK_CTX(3);
        ATT_LOADK(0, 2); ATT_QK_NB(1, 1); ATT_QK_CTX(4); ATT_QK_CTX(5);
        ATT_LOADK(1, 3); ATT_QK_NB(0, 2); ATT_QK_CTX(6); ATT_QK_CTX(7);
        ATT_QK_NB(1, 3);
#undef ATT_LOADK
#undef ATT_QK_NB
        const int cq = 16 * jg + li, cs = min(max(cq - 8, 0), 48);
#pragma unroll
        for (int ch = 0; ch < NNB; ++ch) { const int dr = rs + ch - r + 7;
#pragma unroll
            for (int t = 0; t < 2; ++t)
#pragma unroll
                for (int e = 0; e < 4; ++e) { const int kc = kwin0 + 8 * gq + 4 * t + e; const bool valid = (kc >= cs) && (kc < cs + 16);
                    const int dc = min(max(kc - cq + 15, 0), 30); const float bias = rpbL[dr * 31 + dc];
                    s[ch][t][e] = valid ? s[ch][t][e] + bias : -1e30f; } }
    } else {
#pragma unroll
        for (int cc = 0; cc < 8; ++cc) ATT_QK_CTX(cc);
    }
#undef ATT_QK_CTX
    float mx = -1e30f;
#pragma unroll
    for (int ch = 0; ch < NCH; ++ch)
#pragma unroll
        for (int t = 0; t < 2; ++t)
#pragma unroll
            for (int e = 0; e < 4; ++e) mx = fmaxf(mx, s[ch][t][e]);
    mx = fmaxf(mx, pg8::xshfl<16>(mx)); mx = fmaxf(mx, pg8::xshfl32(mx, lane));
    float lsum = 0.f; bf16x8 pf[NCH];
#pragma unroll
    for (int ch = 0; ch < NCH; ++ch) { float p[8];
#pragma unroll
        for (int t = 0; t < 2; ++t)
#pragma unroll
            for (int e = 0; e < 4; ++e) { p[4 * t + e] = __builtin_amdgcn_exp2f(s[ch][t][e] - mx); lsum += p[4 * t + e]; }
        v4u w; w.x = pk2(p[0], p[1]); w.y = pk2(p[2], p[3]); w.z = pk2(p[4], p[5]); w.w = pk2(p[6], p[7]);
        pf[ch] = __builtin_bit_cast(bf16x8, w); }
    lsum += pg8::xshfl<16>(lsum); lsum += pg8::xshfl32(lsum, lane);
    const float inv = 1.0f / lsum;
    f32x4 o[4];
    const LAS unsigned char* vl = lds + ATT_CV + li * ATT_CVP + gq * 16;
    if constexpr (!CTXQ) {
        bf16x8 vb[2][2][8];
        const bf16* vg = VT + (size_t)(h * 64 + li) * MA + nbbase + 8 * gq;
#define ATT_LOADV(buf, half) do { _Pragma("unroll") for (int d2 = 0; d2 < 2; ++d2) _Pragma("unroll") for (int ch = 0; ch < 8; ++ch) \
        vb[buf][d2][ch] = *(const bf16x8*)(vg + (size_t)(2 * (half) + d2) * 16 * MA + ch * 64); __builtin_amdgcn_sched_barrier(0); } while (0)
#define ATT_PV_CTX(half) do { _Pragma("unroll") for (int d2 = 0; d2 < 2; ++d2) { const int db = 2 * (half) + d2; f32x4 oo = (f32x4){0.f, 0.f, 0.f, 0.f}; \
        _Pragma("unroll") for (int cc = 0; cc < 8; ++cc) { const bf16x8 vf = *(const LAS bf16x8*)(vl + db * 16 * ATT_CVP + cc * 64); oo = __builtin_amdgcn_mfma_f32_16x16x32_bf16(vf, pf[8 + cc], oo, 0, 0, 0); } \
        o[db] = oo; } __builtin_amdgcn_sched_barrier(0); } while (0)
#define ATT_PV_NB(buf, half) do { _Pragma("unroll") for (int d2 = 0; d2 < 2; ++d2) _Pragma("unroll") for (int ch = 0; ch < 8; ++ch) \
        o[2 * (half) + d2] = __builtin_amdgcn_mfma_f32_16x16x32_bf16(vb[buf][d2][ch], pf[ch], o[2 * (half) + d2], 0, 0, 0); __builtin_amdgcn_sched_barrier(0); } while (0)
        ATT_LOADV(0, 0); ATT_PV_CTX(0); ATT_LOADV(1, 1); ATT_PV_NB(0, 0); ATT_PV_CTX(1); ATT_PV_NB(1, 1);
#undef ATT_LOADV
#undef ATT_PV_CTX
#undef ATT_PV_NB
    } else {
#pragma unroll
        for (int db = 0; db < 4; ++db) { f32x4 oo = (f32x4){0.f, 0.f, 0.f, 0.f};
#pragma unroll
            for (int cc = 0; cc < 8; ++cc) { const bf16x8 vf = *(const LAS bf16x8*)(vl + db * 16 * ATT_CVP + cc * 64); oo = __builtin_amdgcn_mfma_f32_16x16x32_bf16(vf, pf[cc], oo, 0, 0, 0); }
            o[db] = oo; }
    }
#pragma unroll
    for (int db = 0; db < 4; ++db) { v2u w; w.x = pk2(o[db][0] * inv, o[db][1] * inv); w.y = pk2(o[db][2] * inv, o[db][3] * inv);
        *(v2u*)(O + (size_t)(qtok0 + li) * 1024 + h * 64 + 16 * db + 4 * gq) = w; }
}

__device__ __forceinline__ void attn_phase(unsigned char* ws, LAS unsigned char* lds, int j, bool ctxq, int tid, int lane, int wave, int vcu, int G) {
    const bf16* QK = (const bf16*)(ws + WS_QK); const bf16* VT = (const bf16*)(ws + WS_VT); bf16* O = (bf16*)(ws + WS_O);
    int Gl = G; asm volatile("" : "+s"(Gl));
    const int per = __builtin_amdgcn_readfirstlane((2048 + Gl - 1) / Gl);
    int cur_bh = -1;
    for (int u = vcu * per; u < min((vcu + 1) * per, 2048); ++u) {
        const int bh = u >> 5, rp = u & 31, b = bh >> 4, h = bh & 15;
        if (bh != cur_bh) {
            cur_bh = bh;
            __syncthreads();
            if (tid < 465) ((LAS float*)(lds + ATT_RPB))[tid] = ((const float*)(ws + WS_PRM))[PRM_RPB + (j * 16 + h) * 465 + tid];
            const int cxbase = ML + b * CTXL;
#pragma unroll
            for (int i = 0; i < 4; ++i) { const int c = tid + 512 * i;
                { const int key = c >> 3, part = c & 7; *(LAS v4u*)(lds + ATT_CK + key * ATT_CKP + part * 16) = *(const v4u*)(QK + (size_t)(cxbase + key) * 2048 + 1024 + h * 64 + part * 8); }
                { const int d = c >> 5, part = c & 31; *(LAS v4u*)(lds + ATT_CV + d * ATT_CVP + part * 16) = *(const v4u*)(VT + (size_t)(h * 64 + d) * MA + cxbase + part * 8); } }
            __syncthreads();
        }
        const int r = 2 * rp + (wave >> 2), jg = wave & 3;
        attn_wave<false>(QK, VT, O, lds, b, h, r, jg, b * SEQ + r * 64 + 16 * jg, lane);
        if (ctxq && (rp & 15) == 0) attn_wave<true>(QK, VT, O, lds, b, h, 0, 0, ML + b * CTXL + 128 * (rp >> 4) + 16 * wave, lane);
    }
}

#define XB_TMO      128
#define XB_XCNT(j)  (256  + 64 * (j))
#define XB_XSUB(j)  (1280 + 64 * (j))
#define XB_XGEN(j)  (2304 + 64 * (j))
#define XB_TOP      3328
#define XB_TOPGEN   3392
#define XCD_BAR_WORDS 3456
#define XB_SPIN_CAP (1u << 18)

__device__ __forceinline__ unsigned xb_ld(unsigned* p)              { return __hip_atomic_load(p, __ATOMIC_RELAXED, __HIP_MEMORY_SCOPE_AGENT); }
__device__ __forceinline__ unsigned xb_add(unsigned* p, unsigned v) { return __hip_atomic_fetch_add(p, v, __ATOMIC_RELAXED, __HIP_MEMORY_SCOPE_AGENT); }
__device__ __forceinline__ unsigned xb_xcc_id() { return (unsigned)__builtin_amdgcn_s_getreg((3 << 11) | 20) & 0xFu; }
#define XB_SPIN(cond, bar) do { unsigned _sp = 0; while (cond) { __builtin_amdgcn_s_sleep(1); \
    if ((++_sp & 255u) == 0u) { if (xb_ld(&(bar)[XB_TMO])) break; if (_sp > XB_SPIN_CAP) { atomicAdd(&(bar)[XB_TMO], 1u); break; } } } } while (0)

struct XcdBarrier {
    unsigned* bar; unsigned x;
    volatile LAS unsigned* st;
};

__device__ __forceinline__ XcdBarrier xcd_barrier_post(unsigned* bar, volatile LAS unsigned* st) {
    XcdBarrier b; b.bar = bar; b.x = xb_xcc_id(); b.st = st;
    if (threadIdx.x == 0) (void)xb_add(&bar[XB_XCNT(b.x)], 1u);
    return b;
}
__device__ __forceinline__ void xcd_barrier_complete(unsigned* bar, unsigned x, unsigned& nloc, unsigned& nx) {
    const unsigned G = gridDim.x * gridDim.y * gridDim.z;
    unsigned sum, cnt, mine, sp = 0u;
    for (;;) {
        sum = 0u; cnt = 0u; mine = 0u;
#pragma unroll
        for (unsigned j = 0; j < 16; ++j) { const unsigned c = xb_ld(&bar[XB_XCNT(j)]); sum += c; cnt += (c > 0u) ? 1u : 0u; mine = (j == x) ? c : mine; }
        if (sum == G) break;
        __builtin_amdgcn_s_sleep(1);
        if ((++sp & 255u) == 0u) { if (xb_ld(&bar[XB_TMO])) break; if (sp > XB_SPIN_CAP) { atomicAdd(&bar[XB_TMO], 1u); break; } }
    }
    nloc = mine > 0u ? mine : 1u; nx = cnt > 0u ? cnt : 1u;
}

__device__ __forceinline__ void xcd_barrier(const XcdBarrier& b) {
    asm volatile("s_waitcnt vmcnt(0)" ::: "memory");
    __syncthreads();
    if (threadIdx.x == 0) {
        unsigned* bar = b.bar;
        __builtin_amdgcn_s_waitcnt(0);
        unsigned nloc = b.st[0], nx = b.st[1];
        if (nloc == 0u) { xcd_barrier_complete(bar, b.x, nloc, nx); b.st[0] = nloc; b.st[1] = nx; }
        const unsigned old = xb_add(&bar[XB_XSUB(b.x)], 1u);
        const unsigned gen = old / nloc;
        if (old + 1u == (gen + 1u) * nloc) {
            __builtin_amdgcn_fence(__ATOMIC_RELEASE, "agent");
            asm volatile("s_waitcnt vmcnt(0)" ::: "memory");
            const unsigned og = xb_add(&bar[XB_TOP], 1u);
            const unsigned tg = og / nx;
            if (og + 1u == (tg + 1u) * nx) xb_add(&bar[XB_TOPGEN], 1u);
            else XB_SPIN(xb_ld(&bar[XB_TOPGEN]) == tg, bar);
            __builtin_amdgcn_fence(__ATOMIC_ACQUIRE, "agent");
            xb_add(&bar[XB_XGEN(b.x)], 1u);
            asm volatile("s_waitcnt vmcnt(0)" ::: "memory");
        } else {
            XB_SPIN(xb_ld(&bar[XB_XGEN(b.x)]) == gen, bar);
            __builtin_amdgcn_fence(__ATOMIC_ACQUIRE, "agent");
            asm volatile("s_waitcnt vmcnt(0)" ::: "memory");
        }
    }
    __syncthreads();
}

constexpr size_t WS_BAR = 0;
__global__ void __launch_bounds__(NT, 2) mega(Args a) {
    extern __shared__ __attribute__((aligned(16))) unsigned char lds_raw[];
    LAS unsigned char* lds = (LAS unsigned char*)lds_raw;
    cg::grid_group grid = cg::this_grid();
#ifndef PROBE_SYNC
#define PROBE_SYNC 0
#endif
#ifndef PROBE_ATTN
#define PROBE_ATTN 0
#endif
#ifndef PROBE_MIX
#define PROBE_MIX 0
#endif
#ifndef PROBE_ROW
#define PROBE_ROW 0
#endif
#ifndef PROBE_PRO
#define PROBE_PRO 0
#endif
    volatile LAS unsigned* bst = (volatile LAS unsigned*)(lds + 131072);
    if (threadIdx.x < 2) bst[threadIdx.x] = 0u;
    if (blockIdx.x == 0) for (int t = threadIdx.x; t < XCD_BAR_WORDS; t += NT) __hip_atomic_store((unsigned*)(a.ws + WS_BAR) + t, 0u, __ATOMIC_RELAXED, __HIP_MEMORY_SCOPE_AGENT);
    XcdBarrier xbar;
#define GSYNC() do { xcd_barrier(xbar); if (PROBE_SYNC) xcd_barrier(xbar); } while (0)
    const int G = gridDim.x, bid = blockIdx.x;
    const int vcu = (G % 8 == 0) ? (bid % 8) * (G / 8) + bid / 8 : bid;
    const int NGW = G * NWAVES;
#define TIDS() int tid = threadIdx.x; asm volatile("" : "+v"(tid)); int vcul = vcu; asm volatile("" : "+s"(vcul)); const int lane = tid & 63, wave = __builtin_amdgcn_readfirstlane(tid >> 6), gw = vcul * NWAVES + wave; (void)lane; (void)gw
    unsigned char* ws = a.ws; float* out = a.out;
    bf16* HN = (bf16*)(ws + WS_HN);
    const float* MOD = (const float*)(ws + WS_MOD);

    { TIDS(); prologue(a, lds, tid, lane, wave, bid, G, gw, NGW); if (PROBE_PRO) { __syncthreads(); prologue(a, lds, tid, lane, wave, bid, G, gw, NGW); } }
    grid.sync();
    xbar = xcd_barrier_post((unsigned*)(a.ws + WS_BAR), bst);
#pragma unroll 1
    for (int i = 0; i < 4; ++i) {
        const bool odd = (i & 1) != 0, last = (i == 3); const int j = i >> 1; const int Mact = last ? ML : MA;
        { TIDS(); rowpass(ws, i, 0, MA, i > 0 ? 11 : 0, MOD + (size_t)((i > 0 ? i - 1 : 0) * 5 + 4) * 6144 + 5 * 1024, lane, gw, NGW); if (PROBE_ROW) rowpass(ws, i, 0, MA, i > 0 ? 11 : 0, MOD + (size_t)((i > 0 ? i - 1 : 0) * 5 + 4) * 6144 + 5 * 1024, lane, gw, NGW); }
        GSYNC();
        if (odd) {
            { pg8::Gemm g{HN, (const bf16*)(ws + WS_WQKV) + (size_t)j * 3072 * 1024, MA, 2048, 1024}; pg8::StaticOrder S; S.init(MA, 2048, 1024, G, bid);
              pg8::EpiStoreBf16 E{(bf16*)(ws + WS_QK), 2048, 0, 4, 0.125f * LOG2E};
              pg8::gemm_phase<pg8::EpiStoreBf16, pg8::StaticOrder, true, true>(lds, g, S, E); }
            { pg8::Gemm g{(const bf16*)(ws + WS_WQKV) + (size_t)j * 3072 * 1024 + (size_t)2048 * 1024, HN, 1024, MA, 1024}; pg8::StaticOrder S; S.init(1024, MA, 1024, G, (bid + G - (544 % G)) % G);
              pg8::EpiStoreBf16 E{(bf16*)(ws + WS_VT), MA, 0, 0, 1.f};
              pg8::gemm_phase<pg8::EpiStoreBf16, pg8::StaticOrder, true, true>(lds, g, S, E); }
        } else {
            { pg8::Gemm g{HN, (const bf16*)(ws + WS_WIN) + (size_t)j * 1536 * 1024, MA, 1024, 1024}; pg8::StaticOrder S; S.init(MA, 1024, 1024, G, bid);
              pg8::EpiStoreBf16 E{(bf16*)(ws + WS_UQ), 1024, 2, 0, 1.f};
              pg8::gemm_phase<pg8::EpiStoreBf16, pg8::StaticOrder, true, true>(lds, g, S, E); }
            { pg8::Gemm g{(const bf16*)(ws + WS_WIN) + (size_t)j * 1536 * 1024 + (size_t)1024 * 1024, HN, 512, MA, 1024}; pg8::StaticOrder S; S.init(512, MA, 1024, G, (bid + G - (272 % G)) % G);
              pg8::EpiGVt E{(bf16*)(ws + WS_GVT), MA, (float*)(ws + WS_STATS)};
              pg8::gemm_phase<pg8::EpiGVt, pg8::StaticOrder, true, true>(lds, g, S, E); }
        }
        GSYNC();
        if (odd) { TIDS(); attn_phase(ws, lds, j, !last, tid, lane, wave, vcul, G); if (PROBE_ATTN) { __syncthreads(); attn_phase(ws, lds, j, !last, tid, lane, wave, vcul, G); } }
        else { TIDS(); mix_phase(ws, lds, j, tid, lane, wave, bid, G); if (PROBE_MIX) { __syncthreads(); mix_phase(ws, lds, j, tid, lane, wave, bid, G); } }
        GSYNC();
        { pg8::Gemm g{odd ? (const bf16*)(ws + WS_O) : (const bf16*)(ws + WS_Y), odd ? (const bf16*)(ws + WS_WONA) + (size_t)j * 1024 * 1024 : (const bf16*)(ws + WS_WOAB) + (size_t)j * 1024 * 1024, Mact, 1024, 1024};
          pg8::SplitOrder S; S.init(Mact, 1024, 8, G, bid);
          pg8::EpiResGate E{(float*)(ws + WS_XW), MOD + (size_t)i * 5 * 6144 + 2 * 1024, (float*)(ws + WS_PART)};
          pg8::gemm_phase<pg8::EpiResGate, pg8::SplitOrder, true, true>(lds, g, S, E); }
        GSYNC();
        { TIDS(); rowpass(ws, i, 1, Mact, last ? 0 : 8, MOD + (size_t)(i * 5 + 4) * 6144 + 2 * 1024, lane, gw, NGW); if (PROBE_ROW) rowpass(ws, i, 1, Mact, last ? 0 : 8, MOD + (size_t)(i * 5 + 4) * 6144 + 2 * 1024, lane, gw, NGW); }
        GSYNC();
        { pg8::Gemm g{HN, (const bf16*)(ws + WS_WFI) + (size_t)i * NFI * 1024, Mact, NFI, 1024}; pg8::StaticOrder S; S.init(Mact, NFI, 1024, G, bid);
          pg8::EpiSwiGLU E{(bf16*)(ws + WS_H2), DFF};
          pg8::gemm_phase<pg8::EpiSwiGLU, pg8::StaticOrder, true, true>(lds, g, S, E); }
        GSYNC();
        { pg8::Gemm g{(const bf16*)(ws + WS_H2), (const bf16*)(ws + WS_WFO) + (size_t)i * 1024 * DFF, Mact, 1024, DFF}; pg8::SplitOrder S; S.init(Mact, DFF, 11, G, bid);
          pg8::EpiResGate E{(float*)(ws + WS_XW), MOD + (size_t)i * 5 * 6144 + 5 * 1024, (float*)(ws + WS_PART)};
          pg8::gemm_phase<pg8::EpiResGate, pg8::SplitOrder, true, true>(lds, g, S, E); }
        GSYNC();
    }
    { TIDS(); final_norm(ws, out, lane, gw, NGW); }
}

extern "C" void kernel_launch(void* const* d_in, const int* in_sizes, int n_in, void* d_out, int out_size, void* d_ws, size_t ws_size, hipStream_t stream) {
    static int grid = 0;
    if (grid == 0) {
        if (n_in != 21 || ws_size < WS_END) { fprintf(stderr, "kernel_launch: expected 21 inputs and >= %zu bytes of workspace (got %d, %zu)\n", (size_t)WS_END, n_in, ws_size); grid = -1; return; }
        int dev = 0, cus = 0, per_cu = 0;
        (void)hipGetDevice(&dev); (void)hipDeviceGetAttribute(&cus, hipDeviceAttributeMultiprocessorCount, dev);
        if (hipFuncSetAttribute((const void*)mega, hipFuncAttributeMaxDynamicSharedMemorySize, LDS_BYTES) != hipSuccess) fprintf(stderr, "kernel_launch: hipFuncSetAttribute failed\n");
        if (hipOccupancyMaxActiveBlocksPerMultiprocessor(&per_cu, (const void*)mega, NT, LDS_BYTES) != hipSuccess || per_cu < 1) { fprintf(stderr, "kernel_launch: occupancy query says %d\n", per_cu); per_cu = 1; }
        (void)hipGetLastError();
        grid = cus > 0 ? cus : 256;
    }
    if (grid < 0) return;
    Args a{};
    for (int i = 0; i < 21; ++i) a.in[i] = (const float*)d_in[i];
    a.out = (float*)d_out; a.ws = (unsigned char*)d_ws;
    void* args[] = {&a};
    hipError_t e = hipLaunchCooperativeKernel((const void*)mega, dim3(grid), dim3(NT), args, LDS_BYTES, stream);
    if (e != hipSuccess) fprintf(stderr, "kernel_launch: cooperative launch failed: %s (grid %d)\n", hipGetErrorString(e), grid);
}
```

```cpp
#include <hip/hip_runtime.h>
#include <hip/hip_cooperative_groups.h>
#include <cstdio>
#include <cstdint>
namespace cg = cooperative_groups;
namespace pg8 {
#define PG8_LAS __attribute__((address_space(3)))
typedef unsigned short bf16_t;
typedef short bf16x8 __attribute__((ext_vector_type(8)));
typedef float f32x4 __attribute__((ext_vector_type(4)));
typedef unsigned u32x4 __attribute__((ext_vector_type(4)));
constexpr int BM = 256, BK = 64, HALF = 128, HTB = HALF * BK * 2  , STAGE_BYTES = 8 * HTB, NXCD = 8, WGM = 8;

__host__ __device__ __forceinline__ int lds_byte(int r, int c) { const int st = (r >> 4) * 2 + (c >> 5), rr = r & 15, cc = c & 31, ob = rr * 64 + cc * 2; return st * 1024 + (ob ^ (((ob >> 9) & 1) << 5)); }
__host__ __device__ __forceinline__ void stage_rc(int b, int& R, int& C) { const int st = b / 1024, sb = b % 1024, swz = sb ^ (((sb >> 9) & 1) << 5); R = (st >> 1) * 16 + swz / 64; C = (st & 1) * 32 + (swz % 64) / 2; }
__host__ __device__ __forceinline__ int perm32(int rho) { const int n = rho >> 4, i = rho & 15; return 8 * (i >> 2) + 4 * n + (i & 3); }

struct Unit { int pm, pn, kt0, nkt, split; };
struct Gemm { const bf16_t* A; const bf16_t* Bt; int M, N, K; };

struct StaticOrder {
    int nM, nN, nwg, G, c, nkt;
    __host__ __device__ void init(int M, int N, int K, int G_, int c_) { nM = M / BM; nN = N / BM; nwg = nM * nN; G = G_; c = c_; nkt = K / BK; }
    __host__ __device__ bool next(int i, Unit& u) const {
        const long L = (long)i * G + c; if (L >= nwg) return false;
        int wgid = (int)L; { const int q = nwg / NXCD, r = nwg % NXCD, xcd = wgid % NXCD, off = wgid / NXCD; wgid = (xcd < r ? xcd * (q + 1) : r * (q + 1) + (xcd - r) * q) + off; }
        const int nig = WGM * nN, gid = wgid / nig, fm = gid * WGM, gsz = (nM - fm) < WGM ? (nM - fm) : WGM;
        u.pm = fm + ((wgid % nig) % gsz); u.pn = (wgid % nig) / gsz; u.kt0 = 0; u.nkt = nkt; u.split = 0; return true;
    }
    __device__ __forceinline__ void a_ready(const Unit&) const {}
    __device__ __forceinline__ void done(const Unit&) const {}
};

__device__ __forceinline__ unsigned cvt_pk_bf16(float lo, float hi) { unsigned r; asm volatile("v_cvt_pk_bf16_f32 %0, %1, %2" : "=v"(r) : "v"(lo), "v"(hi)); return r; }
typedef float f32x2 __attribute__((ext_vector_type(2)));
struct SplitOrder {
    StaticOrder lat; int nctx, S, G, c, nkt;
    __host__ __device__ void init(int M, int K, int S_, int G_, int c_) { lat.init(M < 16384 ? M : 16384, 1024, K, G_, c_); nctx = M > 16384 ? ((M - 16384) / BM) * 4 : 0; S = S_; G = G_; c = c_; nkt = K / BK; }
    __host__ __device__ __forceinline__ bool next(int i, Unit& u) const {
        const int L = i * G + c; const bool isLat = L < lat.nwg;
        Unit a; a.pm = 0; a.pn = 0; a.kt0 = 0; a.nkt = nkt; a.split = 0;
        const bool okLat = lat.next(i, a);
        const int idx = isLat ? 0 : L - lat.nwg; const int tile = idx / S, piece = idx - tile * S, pk = nkt / S;
        u.pm = isLat ? a.pm : 64 + (tile >> 2); u.pn = isLat ? a.pn : (tile & 3); u.nkt = isLat ? nkt : pk; u.kt0 = isLat ? 0 : piece * pk; u.split = isLat ? 0 : 1;
        return isLat ? okLat : (idx < nctx * S);
    }
    __device__ __forceinline__ void a_ready(const Unit&) const {}
    __device__ __forceinline__ void done(const Unit&) const {}
};
__device__ __forceinline__ float gelu_tanh_f(float x) {
    const float y = x * (0.7978845608f + 0.0356774081f * x * x);
    const float e = __builtin_amdgcn_exp2f(-2.885390082f * y);
    return x * __builtin_amdgcn_rcpf(1.0f + e);
}
template <int O> __device__ __forceinline__ float xshfl(float v) { static_assert(O < 32, "xshfl<O>: O < 32"); return __uint_as_float((unsigned)__builtin_amdgcn_ds_swizzle((int)__float_as_uint(v), (O << 10) | 0x1f)); }
__device__ __forceinline__ float xshfl32(float v, int lane) { return __uint_as_float((unsigned)__builtin_amdgcn_ds_bpermute((lane ^ 32) << 2, (int)__float_as_uint(v))); }
__device__ __forceinline__ float silu_f(float x) { return x * __builtin_amdgcn_rcpf(1.0f + __builtin_amdgcn_exp2f(-1.4426950409f * x)); }

struct EpiStoreBf16 {
    static constexpr bool PERM = true, AFTER_DRAIN = false;
    bf16_t* O; int ldc; int gelu_pn_lt; int scale_pn_lt; float scale0;
    __device__ __forceinline__ void operator()(const f32x4 (&acc)[2][2][4][2], const Unit& u, int wr, int wc, int fr, int fq) const {
        const int row0 = u.pm * BM + wr * 64 + fr; const int col0 = u.pn * BM + wc * 32 + 8 * fq;
        const bool act = u.pn < gelu_pn_lt; const float sc = (u.pn < scale_pn_lt) ? scale0 : 1.f;
#pragma unroll
        for (int ai = 0; ai < 2; ++ai)
#pragma unroll
            for (int m = 0; m < 4; ++m) { bf16_t* rowp = O + (size_t)(row0 + ai * HALF + m * 16) * ldc + col0;
#pragma unroll
                for (int bj = 0; bj < 2; ++bj) { f32x4 v0 = acc[ai][bj][m][0], v1 = acc[ai][bj][m][1];
                    if (act) {
#pragma unroll
                        for (int e = 0; e < 4; ++e) { v0[e] = gelu_tanh_f(v0[e]); v1[e] = gelu_tanh_f(v1[e]); } }
                    v0 = v0 * sc; v1 = v1 * sc; u32x4 w; w.x = cvt_pk_bf16(v0[0], v0[1]); w.y = cvt_pk_bf16(v0[2], v0[3]); w.z = cvt_pk_bf16(v1[0], v1[1]); w.w = cvt_pk_bf16(v1[2], v1[3]);
                    *(u32x4*)(rowp + bj * HALF) = w; } }
    }
};

struct EpiGVt {
    static constexpr bool PERM = true, AFTER_DRAIN = false;
    bf16_t* O; int ldc; float* stats;
    __device__ __forceinline__ void operator()(const f32x4 (&acc)[2][2][4][2], const Unit& u, int wr, int wc, int fr, int fq) const {
        const int row0 = u.pm * BM + wr * 64 + fr; const int col0 = u.pn * BM + wc * 32 + 8 * fq;
        const int slot = u.pm * 2 + wr;
#pragma unroll
        for (int bj = 0; bj < 2; ++bj) {
            float s[2][4], q[2][4];
#pragma unroll
            for (int n = 0; n < 2; ++n)
#pragma unroll
                for (int e = 0; e < 4; ++e) { s[n][e] = 0.f; q[n][e] = 0.f; }
#pragma unroll
            for (int ai = 0; ai < 2; ++ai)
#pragma unroll
                for (int m = 0; m < 4; ++m) { bf16_t* rowp = O + (size_t)(row0 + ai * HALF + m * 16) * ldc + col0;
                    f32x4 v0 = acc[ai][bj][m][0], v1 = acc[ai][bj][m][1];
#pragma unroll
                    for (int e = 0; e < 4; ++e) { v0[e] = gelu_tanh_f(v0[e]); v1[e] = gelu_tanh_f(v1[e]);
                        s[0][e] += v0[e]; q[0][e] += v0[e] * v0[e]; s[1][e] += v1[e]; q[1][e] += v1[e] * v1[e]; }
                    u32x4 w; w.x = cvt_pk_bf16(v0[0], v0[1]); w.y = cvt_pk_bf16(v0[2], v0[3]); w.z = cvt_pk_bf16(v1[0], v1[1]); w.w = cvt_pk_bf16(v1[2], v1[3]);
                    *(u32x4*)(rowp + bj * HALF) = w; }
#pragma unroll
            for (int n = 0; n < 2; ++n)
#pragma unroll
                for (int e = 0; e < 4; ++e) { float a = s[n][e], b = q[n][e];
                    a += xshfl<1>(a); b += xshfl<1>(b); a += xshfl<2>(a); b += xshfl<2>(b); a += xshfl<4>(a); b += xshfl<4>(b); a += xshfl<8>(a); b += xshfl<8>(b);
                    if (fr == 0) { float* p = stats + ((size_t)(col0 + bj * HALF + 4 * n + e) * 4 + slot) * 2; p[0] = a; p[1] = b; } }
            asm volatile("" ::: "memory");
        }
    }
};

struct EpiResGate {
    static constexpr bool PERM = false, AFTER_DRAIN = false;
    float* X; const float* gate_base; float* part;
    __device__ __forceinline__ void operator()(const f32x4 (&acc)[2][2][4][2], const Unit& u, int wr, int wc, int fr, int fq) const {
        const int col0 = u.pn * BM + wc * 32 + 4 * fq;
        if (u.split) {
            float* pb = part + ((size_t)(u.kt0 / u.nkt) * 1024 + (size_t)(u.pm - 64) * BM) * 1024 + col0;
#pragma unroll
            for (int ai = 0; ai < 2; ++ai)
#pragma unroll
                for (int m = 0; m < 4; ++m)
#pragma unroll
                    for (int bj = 0; bj < 2; ++bj)
#pragma unroll
                        for (int n = 0; n < 2; ++n) *(f32x4*)(pb + (size_t)(ai * HALF + wr * 64 + m * 16 + fr) * 1024 + bj * HALF + n * 16) = acc[ai][bj][m][n];
            return; }
        const int cond = u.pm < 64 ? (u.pm >> 4) : 4; const float* gate = gate_base + cond * 6144;
        f32x4 gv[2][2];
#pragma unroll
        for (int bj = 0; bj < 2; ++bj)
#pragma unroll
            for (int n = 0; n < 2; ++n) gv[bj][n] = *(const f32x4*)(gate + col0 + bj * HALF + n * 16);
#pragma unroll
        for (int ai = 0; ai < 2; ++ai)
#pragma unroll
            for (int m = 0; m < 4; ++m) { float* rowp = X + (size_t)(u.pm * BM + ai * HALF + wr * 64 + m * 16 + fr) * 1024 + col0;
#pragma unroll
                for (int bj = 0; bj < 2; ++bj)
#pragma unroll
                    for (int n = 0; n < 2; ++n) { float* p = rowp + bj * HALF + n * 16; const f32x4 v = gv[bj][n] * acc[ai][bj][m][n];
                        *(f32x4*)p = *(const f32x4*)p + v; } }
    }
};

struct EpiSwiGLU {
    static constexpr bool PERM = true, AFTER_DRAIN = false;
    bf16_t* O; int ldc;
    __device__ __forceinline__ void operator()(const f32x4 (&acc)[2][2][4][2], const Unit& u, int wr, int wc, int fr, int fq) const {
        const int row0 = u.pm * BM + wr * 64 + fr; const int col0 = u.pn * HALF + wc * 32 + 8 * fq;
#pragma unroll
        for (int ai = 0; ai < 2; ++ai)
#pragma unroll
            for (int m = 0; m < 4; ++m) { bf16_t* rowp = O + (size_t)(row0 + ai * HALF + m * 16) * ldc + col0;
                f32x4 v0, v1;
#pragma unroll
                for (int e = 0; e < 4; ++e) { v0[e] = silu_f(acc[ai][0][m][0][e]) * acc[ai][1][m][0][e]; v1[e] = silu_f(acc[ai][0][m][1][e]) * acc[ai][1][m][1][e]; }
                u32x4 w; w.x = cvt_pk_bf16(v0[0], v0[1]); w.y = cvt_pk_bf16(v0[2], v0[3]); w.z = cvt_pk_bf16(v1[0], v1[1]); w.w = cvt_pk_bf16(v1[2], v1[3]);
                *(u32x4*)rowp = w; }
    }
};

template <class Epi, class Sched, bool ALIGN_EPI = false, bool SP2 = false>
__device__ __forceinline__ void gemm_phase(PG8_LAS unsigned char* lds, const Gemm g, const Sched& S, const Epi& E, int tid_in) {
    int tid_l = tid_in; asm volatile("" : "+v"(tid_l));
    const int tid = tid_l, wid = __builtin_amdgcn_readfirstlane(tid >> 6), lane = tid & 63, wr = wid >> 2, wc = wid & 3, fr = lane & 15, fq = lane >> 4;
    const int K = g.K;
    unsigned voffA[2], voffB[2];
#pragma unroll
    for (int i = 0; i < 2; ++i) { int R, C; stage_rc(tid * 16 + i * 8192, R, C); const int Rb = Epi::PERM ? ((R & ~31) + perm32(R & 31)) : R;
        voffA[i] = (unsigned)(R * K + C) * 2u; voffB[i] = (unsigned)(Rb * K + C) * 2u; }
    const size_t kstep = (size_t)(BK * 2);
    const size_t hstep = (size_t)HALF * K * 2;
    const size_t tstep = 2 * hstep;
    const unsigned ldsw = (unsigned)wid * 1024u;
    const int aoff = lds_byte(wr * 64 + fr, fq * 8), boff = lds_byte(wc * 32 + fr, fq * 8);
#define PG8_SA(b, h) (((b) * 2 + (h)) * HTB)
#define PG8_SB(b, h) ((4 + (b) * 2 + (h)) * HTB)
#define PG8_STAGE(bufoff, gbase, voff) do { _Pragma("unroll") for (int _i = 0; _i < 2; ++_i) \
        __builtin_amdgcn_global_load_lds((const unsigned*)((const char*)(gbase) + (voff)[_i]), (PG8_LAS unsigned*)(lds + (bufoff) + ldsw + _i * 8192), 16, 0, 0); } while (0)
#define PG8_LDA(dst, b, h) do { _Pragma("unroll") for (int m = 0; m < 4; ++m) _Pragma("unroll") for (int k = 0; k < 2; ++k) dst[m][k] = *(const PG8_LAS bf16x8*)(lds + PG8_SA(b, h) + aoff + m * 2048 + k * 1024); } while (0)
#define PG8_LDB(dst, b, h) do { _Pragma("unroll") for (int n = 0; n < 2; ++n) _Pragma("unroll") for (int k = 0; k < 2; ++k) dst[n][k] = *(const PG8_LAS bf16x8*)(lds + PG8_SB(b, h) + boff + n * 2048 + k * 1024); } while (0)
#define PG8_MMA(ai, bj, At, Bt) do { __builtin_amdgcn_s_setprio(1); _Pragma("unroll") for (int m = 0; m < 4; ++m) _Pragma("unroll") for (int n = 0; n < 2; ++n) _Pragma("unroll") for (int k = 0; k < 2; ++k) \
        acc[ai][bj][m][n] = __builtin_amdgcn_mfma_f32_16x16x32_bf16(Bt[n][k], At[m][k], acc[ai][bj][m][n], 0, 0, 0); __builtin_amdgcn_s_setprio(0); } while (0)
#define PG8_WAIT_V(n) asm volatile("s_waitcnt vmcnt(" #n ")" ::: "memory")
#define PG8_WAIT_L(n) asm volatile("s_waitcnt lgkmcnt(" #n ")" ::: "memory")
#define PG8_BAR __builtin_amdgcn_s_barrier()
#define PG8_SCHED __builtin_amdgcn_sched_barrier(0)
    Unit cur, nxt; int ui = 0;
    if (!S.next(0, cur)) return;
    f32x4 acc[2][2][4][2];
#pragma unroll
    for (int a = 0; a < 2; ++a)
#pragma unroll
        for (int b = 0; b < 2; ++b)
#pragma unroll
            for (int m = 0; m < 4; ++m)
#pragma unroll
                for (int n = 0; n < 2; ++n) acc[a][b][m][n] = (f32x4){0.f, 0.f, 0.f, 0.f};
    bf16x8 At[4][2], B0[2][2], B1[2][2];
    const char* cA = (const char*)g.A + (size_t)cur.pm * tstep + (size_t)cur.kt0 * kstep; const char* cB = (const char*)g.Bt + (size_t)cur.pn * tstep + (size_t)cur.kt0 * kstep;
    S.a_ready(cur);
    if constexpr (SP2) {
        PG8_STAGE(PG8_SB(0, 0), cB, voffB); PG8_STAGE(PG8_SB(0, 1), cB + hstep, voffB); PG8_STAGE(PG8_SA(0, 0), cA, voffA); PG8_STAGE(PG8_SA(0, 1), cA + hstep, voffA);
        if (wr == 1) PG8_BAR;
        PG8_WAIT_V(2); PG8_BAR;
        PG8_STAGE(PG8_SB(1, 0), cB + kstep, voffB); PG8_STAGE(PG8_SA(1, 0), cA + kstep, voffA); PG8_STAGE(PG8_SB(1, 1), cB + hstep + kstep, voffB);
        PG8_WAIT_V(6); PG8_BAR;
    } else {
        PG8_STAGE(PG8_SB(0, 0), cB, voffB); PG8_STAGE(PG8_SA(0, 0), cA, voffA); PG8_STAGE(PG8_SB(0, 1), cB + hstep, voffB); PG8_STAGE(PG8_SA(0, 1), cA + hstep, voffA);
        if (wr == 1) PG8_BAR;
        PG8_WAIT_V(4); PG8_BAR;
        PG8_STAGE(PG8_SB(1, 0), cB + kstep, voffB); PG8_STAGE(PG8_SA(1, 0), cA + kstep, voffA); PG8_STAGE(PG8_SB(1, 1), cB + hstep + kstep, voffB);
        PG8_WAIT_V(6); PG8_BAR;
    }
    for (;;) {
        const bool has_next = S.next(ui + 1, nxt);
        const char* nA = has_next ? (const char*)g.A + (size_t)nxt.pm * tstep + (size_t)nxt.kt0 * kstep : cA; const char* nB = has_next ? (const char*)g.Bt + (size_t)nxt.pn * tstep + (size_t)nxt.kt0 * kstep : cB;
        const int nt = cur.nkt;
        for (int t = 0; t < nt; t += 2) {
            const bool last = (t == nt - 2);
            const char* a1 = cA + (size_t)(t + 1) * kstep;
            const char* a2 = last ? nA : cA + (size_t)(t + 2) * kstep; const char* b2 = last ? nB : cB + (size_t)(t + 2) * kstep;
            const char* a3 = a2 + kstep; const char* b3 = b2 + kstep;
            if (last && has_next) S.a_ready(nxt);
            if constexpr (SP2) {
            PG8_LDB(B0, 0, 0); PG8_LDB(B1, 0, 1); PG8_SCHED; PG8_LDA(At, 0, 0); PG8_STAGE(PG8_SA(1, 1), a1 + hstep, voffA);
            PG8_WAIT_V(8); PG8_WAIT_L(0); PG8_BAR; PG8_MMA(0, 0, At, B0); PG8_MMA(0, 1, At, B1); PG8_BAR; PG8_SCHED;
            PG8_LDA(At, 0, 1); PG8_STAGE(PG8_SB(0, 0), b2, voffB); PG8_STAGE(PG8_SB(0, 1), b2 + hstep, voffB); PG8_STAGE(PG8_SA(0, 0), a2, voffA);
            PG8_WAIT_V(8); PG8_WAIT_L(0); PG8_BAR; PG8_MMA(1, 0, At, B0); PG8_MMA(1, 1, At, B1); PG8_BAR; PG8_SCHED;
            PG8_LDB(B0, 1, 0); PG8_LDB(B1, 1, 1); PG8_SCHED; PG8_LDA(At, 1, 0); PG8_STAGE(PG8_SA(0, 1), a2 + hstep, voffA);
            PG8_WAIT_V(8); PG8_WAIT_L(0); PG8_BAR; PG8_MMA(0, 0, At, B0); PG8_MMA(0, 1, At, B1); PG8_BAR; PG8_SCHED;
            PG8_LDA(At, 1, 1); PG8_STAGE(PG8_SB(1, 0), b3, voffB); PG8_STAGE(PG8_SB(1, 1), b3 + hstep, voffB); PG8_STAGE(PG8_SA(1, 0), a3, voffA);
            PG8_WAIT_V(8); PG8_WAIT_L(0); PG8_BAR; PG8_MMA(1, 0, At, B0); PG8_MMA(1, 1, At, B1); PG8_BAR; PG8_SCHED;
            } else {
            PG8_LDB(B0, 0, 0); PG8_SCHED; PG8_LDA(At, 0, 0); PG8_STAGE(PG8_SA(1, 1), a1 + hstep, voffA);
            PG8_WAIT_L(8); PG8_BAR; PG8_WAIT_L(0); PG8_MMA(0, 0, At, B0); PG8_BAR; PG8_SCHED;
            PG8_LDB(B1, 0, 1); PG8_STAGE(PG8_SB(0, 0), b2, voffB);
            PG8_BAR; PG8_WAIT_L(0); PG8_MMA(0, 1, At, B1); PG8_BAR;
            PG8_LDA(At, 0, 1); PG8_STAGE(PG8_SA(0, 0), a2, voffA);
            PG8_BAR; PG8_WAIT_L(0); PG8_MMA(1, 0, At, B0); PG8_BAR; PG8_SCHED;
            PG8_STAGE(PG8_SB(0, 1), b2 + hstep, voffB);
            PG8_WAIT_V(6); PG8_BAR; PG8_MMA(1, 1, At, B1); PG8_BAR;
            PG8_LDB(B0, 1, 0); PG8_SCHED; PG8_LDA(At, 1, 0); PG8_STAGE(PG8_SA(0, 1), a2 + hstep, voffA);
            PG8_WAIT_L(8); PG8_BAR; PG8_WAIT_L(0); PG8_MMA(0, 0, At, B0); PG8_BAR; PG8_SCHED;
            PG8_LDB(B1, 1, 1); PG8_STAGE(PG8_SB(1, 0), b3, voffB);
            PG8_BAR; PG8_WAIT_L(0); PG8_MMA(0, 1, At, B1); PG8_BAR;
            PG8_LDA(At, 1, 1); PG8_STAGE(PG8_SA(1, 0), a3, voffA);
            PG8_BAR; PG8_WAIT_L(0); PG8_MMA(1, 0, At, B0); PG8_BAR; PG8_SCHED;
            PG8_STAGE(PG8_SB(1, 1), b3 + hstep, voffB);
            PG8_WAIT_V(6); PG8_BAR; PG8_MMA(1, 1, At, B1); PG8_BAR;
            }
        }
        if constexpr (ALIGN_EPI) { if (wr == 0) PG8_BAR; }
        if constexpr (!Epi::AFTER_DRAIN) { E(acc, cur, wr, wc, fr, fq); S.done(cur); }
        if (!has_next) break;
#pragma unroll
        for (int a = 0; a < 2; ++a)
#pragma unroll
            for (int b = 0; b < 2; ++b)
#pragma unroll
                for (int m = 0; m < 4; ++m)
#pragma unroll
                    for (int n = 0; n < 2; ++n) acc[a][b][m][n] = (f32x4){0.f, 0.f, 0.f, 0.f};
        cur = nxt; cA = nA; cB = nB; ++ui;
        if constexpr (ALIGN_EPI) { if (wr == 1) PG8_BAR; }
    }
    PG8_WAIT_V(0);
    if constexpr (!ALIGN_EPI) { if (wr == 0) PG8_BAR; }
    PG8_BAR;
    if constexpr (Epi::AFTER_DRAIN) { E.fused(acc, cur, wr, wc, fr, fq, lds, wid, lane); S.done(cur); }
#undef PG8_SA
#undef PG8_SB
#undef PG8_STAGE
#undef PG8_LDA
#undef PG8_LDB
#undef PG8_MMA
#undef PG8_WAIT_V
#undef PG8_WAIT_L
#undef PG8_BAR
#undef PG8_SCHED
}
}
#define LAS __attribute__((address_space(3)))
typedef unsigned short bf16;
typedef unsigned v4u __attribute__((ext_vector_type(4)));
typedef unsigned v2u __attribute__((ext_vector_type(2)));
typedef float f32x4 __attribute__((ext_vector_type(4)));
typedef short bf16x8 __attribute__((ext_vector_type(8)));

constexpr int NWAVES = 8, NT = 512;
constexpr int D = 1024, ML = 16384, MC = 1024, MA = ML + MC, SEQ = 4096, CTXL = 256, DFF = 2816, NFI = 2 * DFF;
constexpr float EPS = 1e-6f, LOG2E = 1.4426950408889634f;
constexpr size_t MiB = 1u << 20;
constexpr size_t WS_MOD = 1 * MiB;
constexpr size_t WS_STATS = 2 * MiB;
constexpr size_t WS_WS = 3 * MiB;
constexpr size_t WS_PRM = 3 * MiB + 512 * 1024;
constexpr int PRM_NMIX = 0, PRM_NFFN = 4096, PRM_LNV = 8192, PRM_BS = 9216, PRM_RPB = 10240, PRM_NFIN = 10240 + 14880, PRM_TOTAL = PRM_NFIN + 1024;
constexpr size_t WS_XW = 4 * MiB;
constexpr size_t WS_HN = 72 * MiB;
constexpr size_t WS_SCR = 106 * MiB;
constexpr size_t WS_H2 = WS_SCR;
constexpr size_t WS_QK = WS_SCR, WS_VT = WS_SCR + 68 * MiB, WS_O = WS_SCR + 102 * MiB;
constexpr size_t WS_UQ = WS_SCR, WS_GVT = WS_SCR + 34 * MiB, WS_Y = WS_SCR + 51 * MiB;
constexpr size_t WS_WIN = 242 * MiB;
constexpr size_t WS_WOAB = 248 * MiB;
constexpr size_t WS_WQKV = 252 * MiB;
constexpr size_t WS_WONA = 264 * MiB;
constexpr size_t WS_WFI = 268 * MiB;
constexpr size_t WS_WFO = 312 * MiB;
constexpr size_t WS_PART = 334 * MiB;
constexpr size_t WS_END = 378 * MiB;
constexpr int LDS_BYTES = 157696;

struct Args { const float* in[21]; float* out; unsigned char* ws; };

__device__ __forceinline__ float bf2f(unsigned b) { return __uint_as_float(b << 16); }
__device__ __forceinline__ unsigned pk2(float lo, float hi) { return pg8::cvt_pk_bf16(lo, hi); }
__device__ __forceinline__ float wave_sum(float v, int lane) {
    v += pg8::xshfl<1>(v); v += pg8::xshfl<2>(v); v += pg8::xshfl<4>(v); v += pg8::xshfl<8>(v); v += pg8::xshfl<16>(v); v += pg8::xshfl32(v, lane);
    return v;
}
#define LDS_WAIT() asm volatile("s_waitcnt lgkmcnt(0)" ::: "memory")

__device__ __forceinline__ void transpose_item(const float* W, int ldw, bf16* WT, int K, int k0, int n0, int drow0, LAS float* scr, int lane) {
#pragma unroll 8
    for (int i = 0; i < 32; ++i) { const int kk = 2 * i + (lane >> 5); scr[kk * 33 + (lane & 31)] = W[(size_t)(k0 + kk) * ldw + n0 + (lane & 31)]; }
    LDS_WAIT();
    const int c = lane & 7;
#pragma unroll
    for (int j = 0; j < 4; ++j) { const int n = (lane >> 3) + 8 * j; const LAS float* s = scr + (8 * c) * 33 + n;
        v4u o; o.x = pk2(s[0 * 33], s[1 * 33]); o.y = pk2(s[2 * 33], s[3 * 33]); o.z = pk2(s[4 * 33], s[5 * 33]); o.w = pk2(s[6 * 33], s[7 * 33]);
        *(v4u*)(WT + (size_t)(drow0 + n) * K + k0 + 8 * c) = o; }
    LDS_WAIT();
}

__device__ __forceinline__ void prologue(const Args& a, LAS unsigned char* lds, int tid, int lane, int wave, int bid, int G, int gw, int NGW) {
    unsigned char* ws = a.ws;
    {
        LAS float* scr = (LAS float*)(lds + wave * 16384);
        constexpr int I_IN = 16 * 32, I_SQ = 16 * 32, I_QKV = 16 * 96, I_FI = 16 * 176, I_FO = 44 * 32;
        constexpr int NITEMS = 2 * I_IN + 2 * I_SQ + 2 * I_QKV + 2 * I_SQ + 4 * I_FI + 4 * I_FO;
        for (int it = gw; it < NITEMS; it += NGW) {
            int r = it;
            if (r < 2 * I_IN) { const int j = r / I_IN; r -= j * I_IN; const int kb = r / 32, nb = r % 32, n0 = nb * 32;
                transpose_item(a.in[8] + (size_t)j * 1024 * 1536, 1536, (bf16*)(ws + WS_WIN) + (size_t)j * 1536 * 1024, 1024, kb * 64, n0, n0 < 512 ? n0 : n0 + 512, scr, lane); continue; } r -= 2 * I_IN;
            if (r < 2 * I_SQ) { const int j = r / I_SQ; r -= j * I_SQ; const int kb = r / 32, nb = r % 32;
                transpose_item(a.in[14] + (size_t)j * 1024 * 1024, 1024, (bf16*)(ws + WS_WOAB) + (size_t)j * 1024 * 1024, 1024, kb * 64, nb * 32, nb * 32, scr, lane); continue; } r -= 2 * I_SQ;
            if (r < 2 * I_QKV) { const int j = r / I_QKV; r -= j * I_QKV; const int kb = r / 96, nb = r % 96;
                transpose_item(a.in[15] + (size_t)j * 1024 * 3072, 3072, (bf16*)(ws + WS_WQKV) + (size_t)j * 3072 * 1024, 1024, kb * 64, nb * 32, nb * 32, scr, lane); continue; } r -= 2 * I_QKV;
            if (r < 2 * I_SQ) { const int j = r / I_SQ; r -= j * I_SQ; const int kb = r / 32, nb = r % 32;
                transpose_item(a.in[17] + (size_t)j * 1024 * 1024, 1024, (bf16*)(ws + WS_WONA) + (size_t)j * 1024 * 1024, 1024, kb * 64, nb * 32, nb * 32, scr, lane); continue; } r -= 2 * I_SQ;
            if (r < 4 * I_FI) { const int i = r / I_FI; r -= i * I_FI; const int kb = r / 176, nb = r % 176, n0 = nb * 32;
                const int jj = n0 < DFF ? n0 : n0 - DFF; const int drow0 = (jj >> 7) * 256 + (n0 < DFF ? 0 : 128) + (jj & 127);
                transpose_item(a.in[18] + (size_t)i * 1024 * NFI, NFI, (bf16*)(ws + WS_WFI) + (size_t)i * NFI * 1024, 1024, kb * 64, n0, drow0, scr, lane); continue; } r -= 4 * I_FI;
            { const int i = r / I_FO; r -= i * I_FO; const int kb = r / 32, nb = r % 32;
                transpose_item(a.in[19] + (size_t)i * DFF * 1024, 1024, (bf16*)(ws + WS_WFO) + (size_t)i * 1024 * DFF, DFF, kb * 64, nb * 32, nb * 32, scr, lane); }
        }
    }
    for (int e = bid * NT + tid; e < 2 * 4 * 128 * 128 / 2; e += G * NT) { const float2 v = *(const float2*)(a.in[10] + 2 * (size_t)e); ((unsigned*)(ws + WS_WS))[e] = pk2(v.x, v.y); }
    {
        float* prm = (float*)(ws + WS_PRM);
        for (int e = bid * NT + tid; e < PRM_TOTAL; e += G * NT) {
            float v;
            if (e < PRM_NFFN) v = a.in[6][e]; else if (e < PRM_LNV) v = a.in[7][e - PRM_NFFN]; else if (e < PRM_BS) v = a.in[9][e - PRM_LNV];
            else if (e < PRM_RPB) v = a.in[11][e - PRM_BS]; else if (e < PRM_NFIN) v = a.in[16][e - PRM_RPB] * LOG2E; else v = a.in[20][e - PRM_NFIN];
            prm[e] = v; }
        f32x4* xw = (f32x4*)(ws + WS_XW);
        for (int e = bid * NT + tid; e < MA * 256; e += G * NT) xw[e] = e < ML * 256 ? ((const f32x4*)a.in[0])[e] : ((const f32x4*)a.in[2])[e - ML * 256];
    }
    __syncthreads();
    for (int it = bid; it < 128; it += G) {
        const int j = it >> 6, g = (it >> 4) & 3, kb = it & 15, k0 = kb * 64;
        LAS float* wp = (LAS float*)lds; LAS float* wi = (LAS float*)(lds + 65536);
        const float* wpool = a.in[12] + (size_t)(j * 4 + g) * 16384;
#pragma unroll 4
        for (int i = 0; i < 32; ++i) wp[tid + 512 * i] = wpool[tid + 512 * i];
        const float* win = a.in[8] + (size_t)j * 1024 * 1536 + 1024 + g * 128;
#pragma unroll 4
        for (int i = 0; i < 16; ++i) { const int kk = (tid >> 7) + 4 * i, c = tid & 127; wi[kk * 129 + c] = win[(size_t)(k0 + kk) * 1536 + c]; }
        __syncthreads();
        const int kk = tid & 63, d0 = (tid >> 6) * 16;
        float acc[16];
#pragma unroll
        for (int i = 0; i < 16; ++i) acc[i] = 0.f;
        for (int c = 0; c < 128; ++c) { const float av = wi[kk * 129 + c];
#pragma unroll
            for (int i = 0; i < 16; ++i) acc[i] += av * wp[c * 128 + d0 + i]; }
        const float* ps = a.in[13] + j * 512 + g * 128 + d0;
        bf16* out = (bf16*)(ws + WS_WIN) + (size_t)j * 1536 * 1024 + (size_t)(512 + g * 128 + d0) * 1024 + k0 + kk;
#pragma unroll
        for (int i = 0; i < 16; ++i) out[(size_t)i * 1024] = (bf16)(pk2(acc[i] * ps[i], 0.f) & 0xffffu);
        __syncthreads();
    }
    {
        LAS float* sv = (LAS float*)lds;
        LAS float* red = (LAS float*)(lds + 20480);
        for (int e = tid; e < 5 * 1024; e += NT) { const float v = e < 4096 ? a.in[1][e] : a.in[3][e - 4096]; sv[e] = pg8::silu_f(v); }
        __syncthreads();
        for (int it = bid; it < 4 * 192; it += G) {
            const int layer = it / 192, n0 = (it % 192) * 32, col = tid & 31, ks = tid >> 5;
            const float* wm = a.in[4] + ((size_t)layer * 1024 + ks * 64) * 6144 + n0 + col;
            float acc[5] = {0.f, 0.f, 0.f, 0.f, 0.f};
#pragma unroll 8
            for (int k = 0; k < 64; ++k) { const float w = wm[(size_t)k * 6144];
#pragma unroll
                for (int c = 0; c < 5; ++c) acc[c] += sv[c * 1024 + ks * 64 + k] * w; }
#pragma unroll
            for (int c = 0; c < 5; ++c) red[(ks * 5 + c) * 32 + col] = acc[c];
            __syncthreads();
            if (tid < 160) { const int c = tid >> 5; float s = a.in[5][layer * 6144 + n0 + col];
#pragma unroll
                for (int q = 0; q < 16; ++q) s += red[(q * 5 + c) * 32 + col];
                ((float*)(ws + WS_MOD))[(size_t)(layer * 5 + c) * 6144 + n0 + col] = s; }
            __syncthreads();
        }
    }
}

__device__ __forceinline__ void rowpass(unsigned char* ws, int layer, int which, int Mrows, int nparts, const float* gate4, int lane, int gw, int NGW) {
    float* XW = (float*)(ws + WS_XW); bf16* HN = (bf16*)(ws + WS_HN);
    const float* gn = (const float*)(ws + WS_PRM) + (which ? PRM_NFFN : PRM_NMIX) + layer * 1024;
    const float* mod = (const float*)(ws + WS_MOD) + (size_t)layer * 5 * 6144 + (which ? 3 : 0) * 1024;
    f32x4 g4[4];
#pragma unroll
    for (int j = 0; j < 4; ++j) g4[j] = *(const f32x4*)(gn + 4 * lane + 256 * j);
    for (int m = gw; m < Mrows; m += NGW) {
        const float* src = XW + (size_t)m * D;
        const int cond = m < ML ? (m >> 12) : 4;
        const float* sh = mod + cond * 6144; const float* sc = sh + 1024;
        f32x4 v[4]; float s = 0.f;
#pragma unroll
        for (int j = 0; j < 4; ++j) v[j] = *(const f32x4*)(src + 4 * lane + 256 * j);
        if (m >= ML && nparts > 0) {
            const float* pp = (const float*)(ws + WS_PART) + (size_t)(m - ML) * 1024 + 4 * lane;
            f32x4 a4[4];
#pragma unroll
            for (int j = 0; j < 4; ++j) a4[j] = (f32x4){0.f, 0.f, 0.f, 0.f};
            for (int p = 0; p < nparts; ++p)
#pragma unroll
                for (int j = 0; j < 4; ++j) a4[j] += *(const f32x4*)(pp + (size_t)p * 1024 * 1024 + 256 * j);
#pragma unroll
            for (int j = 0; j < 4; ++j) { v[j] += *(const f32x4*)(gate4 + 4 * lane + 256 * j) * a4[j]; *(f32x4*)(XW + (size_t)m * D + 4 * lane + 256 * j) = v[j]; }
        }
#pragma unroll
        for (int j = 0; j < 4; ++j) s += (v[j].x * v[j].x + v[j].y * v[j].y) + (v[j].z * v[j].z + v[j].w * v[j].w);
        const float rstd = 1.0f / sqrtf(wave_sum(s, lane) * (1.f / D) + EPS);
#pragma unroll
        for (int j = 0; j < 4; ++j) {
            const f32x4 s4 = *(const f32x4*)(sc + 4 * lane + 256 * j), h4 = *(const f32x4*)(sh + 4 * lane + 256 * j);
            const f32x4 o = (v[j] * rstd) * g4[j] * (s4 + 1.0f) + h4;
            v2u w; w.x = pk2(o.x, o.y); w.y = pk2(o.z, o.w);
            *(v2u*)(HN + (size_t)m * D + 4 * lane + 256 * j) = w; }
    }
}

__device__ __forceinline__ void final_norm(unsigned char* ws, float* out, int lane, int gw, int NGW) {
    const float* XW = (const float*)(ws + WS_XW); const float* gn = (const float*)(ws + WS_PRM) + PRM_NFIN;
    f32x4 g4[4];
#pragma unroll
    for (int j = 0; j < 4; ++j) g4[j] = *(const f32x4*)(gn + 4 * lane + 256 * j);
    for (int m = gw; m < ML; m += NGW) {
        f32x4 v[4]; float s = 0.f;
#pragma unroll
        for (int j = 0; j < 4; ++j) { v[j] = *(const f32x4*)(XW + (size_t)m * D + 4 * lane + 256 * j); s += (v[j].x * v[j].x + v[j].y * v[j].y) + (v[j].z * v[j].z + v[j].w * v[j].w); }
        const float rstd = 1.0f / sqrtf(wave_sum(s, lane) * (1.f / D) + EPS);
#pragma unroll
        for (int j = 0; j < 4; ++j) *(f32x4*)(out + (size_t)m * D + 4 * lane + 256 * j) = (v[j] * rstd) * g4[j];
    }
}

__device__ __forceinline__ void mix_phase(unsigned char* ws, LAS unsigned char* lds, int j, int tid, int lane, int wave, int bid, int G) {
    const float* prm = (const float*)(ws + WS_PRM);
    const bf16* UQ = (const bf16*)(ws + WS_UQ); const bf16* GVT = (const bf16*)(ws + WS_GVT); bf16* Y = (bf16*)(ws + WS_Y);
    const float* stats = (const float*)(ws + WS_STATS); const bf16* WSb = (const bf16*)(ws + WS_WS);
    LAS float* st = (LAS float*)lds;
    const int li = lane & 15, gq = lane >> 4;
    for (int u = bid; u < 136 * 4; u += G) {
        const int chunk = u >> 2, g = u & 3, token0 = chunk * 128;
        int s0, L, seqbase;
        if (chunk < 128) { s0 = (chunk & 31) * 128; L = SEQ; seqbase = (chunk >> 5) * SEQ; } else { const int cc = chunk - 128; s0 = (cc & 1) * 128; L = CTXL; seqbase = ML + (cc >> 1) * CTXL; }
        __syncthreads();
        if (tid < 128) { const float* p = stats + (size_t)(token0 + tid) * 8; const f32x4 p0 = *(const f32x4*)p, p1 = *(const f32x4*)(p + 4);
            const float S = (p0.x + p0.z) + (p1.x + p1.z), Q = (p0.y + p0.w) + (p1.y + p1.w);
            const float mean = S * (1.f / 512.f); const float var = fmaxf(Q * (1.f / 512.f) - mean * mean, 0.f);
            st[2 * tid] = mean; st[2 * tid + 1] = 1.0f / sqrtf(var + EPS); }
        __syncthreads();
        {
            const int c = 16 * wave + li;
            const float lnv = prm[PRM_LNV + j * 512 + g * 128 + c];
            f32x4 acc[8];
#pragma unroll
            for (int ib = 0; ib < 8; ++ib) acc[ib] = (f32x4){0.f, 0.f, 0.f, 0.f};
#pragma unroll
            for (int ks = 0; ks < 4; ++ks) {
                const v4u raw = *(const v4u*)(GVT + (size_t)(g * 128 + c) * MA + token0 + 32 * ks + 8 * gq);
                const LAS f32x4* sp = (const LAS f32x4*)(st + 2 * (32 * ks + 8 * gq));
                const f32x4 m0 = sp[0], m1 = sp[1], m2 = sp[2], m3 = sp[3];
                v4u an;
                an.x = pk2((bf2f(raw.x & 0xffffu) - m0.x) * m0.y * lnv, (bf2f(raw.x >> 16) - m0.z) * m0.w * lnv);
                an.y = pk2((bf2f(raw.y & 0xffffu) - m1.x) * m1.y * lnv, (bf2f(raw.y >> 16) - m1.z) * m1.w * lnv);
                an.z = pk2((bf2f(raw.z & 0xffffu) - m2.x) * m2.y * lnv, (bf2f(raw.z >> 16) - m2.z) * m2.w * lnv);
                an.w = pk2((bf2f(raw.w & 0xffffu) - m3.x) * m3.y * lnv, (bf2f(raw.w >> 16) - m3.z) * m3.w * lnv);
                const bf16x8 af = __builtin_bit_cast(bf16x8, an);
#pragma unroll
                for (int ib = 0; ib < 8; ++ib) {
                    const bf16x8 bfr = *(const bf16x8*)(WSb + ((size_t)((j * 4 + g) * 128 + 16 * ib + li)) * 128 + 32 * ks + 8 * gq);
                    acc[ib] = __builtin_amdgcn_mfma_f32_16x16x32_bf16(af, bfr, acc[ib], 0, 0, 0); }
            }
            const int cc = g * 128 + 16 * wave + 4 * gq;
#pragma unroll
            for (int ib = 0; ib < 8; ++ib) {
                const int tok = token0 + 16 * ib + li;
                const float bs = prm[PRM_BS + (j * 4 + g) * 128 + 16 * ib + li];
                const v2u uu = *(const v2u*)(UQ + (size_t)tok * 1024 + cc);
                v2u o; o.x = pk2(bf2f(uu.x & 0xffffu) * (acc[ib][0] + bs), bf2f(uu.x >> 16) * (acc[ib][1] + bs));
                o.y = pk2(bf2f(uu.y & 0xffffu) * (acc[ib][2] + bs), bf2f(uu.y >> 16) * (acc[ib][3] + bs));
                *(v2u*)(Y + (size_t)tok * 1024 + cc) = o; }
        }
        {
            const int c8 = tid & 15, rg = tid >> 4, hw = 1 << g;
            const int t0 = s0 + 4 * rg;
            const int rlo = max(t0 - hw, 0), rhi = min(t0 + 3 + hw, L);
            float sum[4][8], self[4][8];
#pragma unroll
            for (int tt = 0; tt < 4; ++tt)
#pragma unroll
                for (int e = 0; e < 8; ++e) { sum[tt][e] = 0.f; self[tt][e] = 0.f; }
            const bf16* qb = UQ + (size_t)seqbase * 1024 + 512 + g * 128 + c8 * 8;
            for (int r = rlo; r < rhi; ++r) {
                const v4u raw = *(const v4u*)(qb + (size_t)r * 1024);
                float f[8]; f[0] = bf2f(raw.x & 0xffffu); f[1] = bf2f(raw.x >> 16); f[2] = bf2f(raw.y & 0xffffu); f[3] = bf2f(raw.y >> 16);
                f[4] = bf2f(raw.z & 0xffffu); f[5] = bf2f(raw.z >> 16); f[6] = bf2f(raw.w & 0xffffu); f[7] = bf2f(raw.w >> 16);
#pragma unroll
                for (int tt = 0; tt < 4; ++tt) { const int t = t0 + tt; const bool in = (r >= t - hw) && (r < t + hw); const bool me = (r == t);
#pragma unroll
                    for (int e = 0; e < 8; ++e) { sum[tt][e] += in ? f[e] : 0.f; self[tt][e] = me ? f[e] : self[tt][e]; } }
            }
#pragma unroll
            for (int tt = 0; tt < 4; ++tt) { const int t = t0 + tt; const int lo = max(t - hw, 0), hi = min(t + hw, L); const float inv = 1.0f / (float)(hi - lo);
                v4u o; o.x = pk2(sum[tt][0] * inv - self[tt][0], sum[tt][1] * inv - self[tt][1]); o.y = pk2(sum[tt][2] * inv - self[tt][2], sum[tt][3] * inv - self[tt][3]);
                o.z = pk2(sum[tt][4] * inv - self[tt][4], sum[tt][5] * inv - self[tt][5]); o.w = pk2(sum[tt][6] * inv - self[tt][6], sum[tt][7] * inv - self[tt][7]);
                *(v4u*)(Y + (size_t)(seqbase + t) * 1024 + 512 + g * 128 + c8 * 8) = o; }
        }
    }
}

constexpr int ATT_RPB = 0, ATT_CK = 4096, ATT_CKP = 144, ATT_CV = 40960, ATT_CVP = 528, ATT_KR = 74752, ATT_KRS = 8192, ATT_NSLOT = 10;
__device__ __forceinline__ int att_kswz(int key) { return ((key >> 1) & 1) | (((key >> 3) & 3) << 1); }
template <bool CTXQ>
__device__ __forceinline__ void attn_wave(const bf16x8 (&qf)[2], const bf16* VT, bf16* O, LAS unsigned char* lds, int b, int h, int r, int jg, int qtok0, int lane) {
    const int li = lane & 15, gq = lane >> 4;
    constexpr int NCH = CTXQ ? 8 : 16, NNB = CTXQ ? 0 : 8;
    const LAS float* rpbL = (const LAS float*)(lds + ATT_RPB);
    const int kwin0 = jg == 0 ? 0 : (jg == 1 ? 8 : (jg == 2 ? 24 : 32));
    const int rs = min(max(r - 4, 0), 56);
    const int kofs = (li >> 2) * 8 + (li & 3);
    const int nbbase = b * SEQ + rs * 64 + kwin0;
    const LAS unsigned char* kl = lds + ATT_CK + kofs * ATT_CKP + gq * 16;
    f32x4 s[NCH][2];
    bf16x8 vb[4][8];
    const bf16* vg = VT + (size_t)(h * 64 + li) * MA + nbbase + 8 * gq;
#define ATT_LOADV(db) do { _Pragma("unroll") for (int ch = 0; ch < 8; ++ch) vb[db][ch] = *(const bf16x8*)(vg + (size_t)(db) * 16 * MA + ch * 64); __builtin_amdgcn_sched_barrier(0); } while (0)
#define ATT_QK_CTX(cc) do { _Pragma("unroll") for (int t = 0; t < 2; ++t) { \
        const bf16x8 k0 = *(const LAS bf16x8*)(kl + ((cc) * 32 + 4 * t) * ATT_CKP), k1 = *(const LAS bf16x8*)(kl + ((cc) * 32 + 4 * t) * ATT_CKP + 64); \
        f32x4 c = (f32x4){0.f, 0.f, 0.f, 0.f}; c = __builtin_amdgcn_mfma_f32_16x16x32_bf16(k0, qf[0], c, 0, 0, 0); c = __builtin_amdgcn_mfma_f32_16x16x32_bf16(k1, qf[1], c, 0, 0, 0); s[NNB + (cc)][t] = c; } } while (0)
    if constexpr (!CTXQ) {
        const int key0 = kwin0 + kofs, fz = att_kswz(key0);
        const LAS unsigned char* kr0 = lds + ATT_KR + key0 * 128 + ((gq ^ fz) * 16);
#pragma unroll
        for (int ch = 0; ch < 8; ++ch) { const int row = rs + ch; const int slot = row - (row / ATT_NSLOT) * ATT_NSLOT;
#pragma unroll
            for (int t = 0; t < 2; ++t) {
                const LAS unsigned char* p = kr0 + slot * ATT_KRS + t * 512;
                const bf16x8 k0 = *(const LAS bf16x8*)p, k1 = *(const LAS bf16x8*)(LAS unsigned char*)(size_t)((unsigned)(size_t)p ^ 64u);
                f32x4 c = (f32x4){0.f, 0.f, 0.f, 0.f}; c = __builtin_amdgcn_mfma_f32_16x16x32_bf16(k0, qf[0], c, 0, 0, 0); c = __builtin_amdgcn_mfma_f32_16x16x32_bf16(k1, qf[1], c, 0, 0, 0); s[ch][t] = c; } }
#pragma unroll
        for (int cc = 0; cc < 8; ++cc) ATT_QK_CTX(cc);
        const int cq = 16 * jg + li, cs = min(max(cq - 8, 0), 48);
        const LAS float* bl = rpbL + 32 + (rs - r + 7) * 31 + (kwin0 + 8 * gq - cq + 15);
        bool valid[8];
#pragma unroll
        for (int c = 0; c < 8; ++c) valid[c] = (unsigned)(kwin0 + 8 * gq + c - cs) < 16u;
#pragma unroll
        for (int ch = 0; ch < NNB; ++ch)
#pragma unroll
            for (int t = 0; t < 2; ++t)
#pragma unroll
                for (int e = 0; e < 4; ++e) s[ch][t][e] = valid[4 * t + e] ? s[ch][t][e] + bl[ch * 31 + 4 * t + e] : -1e30f;
    } else {
#pragma unroll
        for (int cc = 0; cc < 8; ++cc) ATT_QK_CTX(cc);
    }
#undef ATT_QK_CTX
    if constexpr (!CTXQ) { ATT_LOADV(0); }
    float mx = -1e30f;
#pragma unroll
    for (int ch = 0; ch < NCH; ++ch)
#pragma unroll
        for (int t = 0; t < 2; ++t)
#pragma unroll
            for (int e = 0; e < 4; ++e) mx = fmaxf(mx, s[ch][t][e]);
    mx = fmaxf(mx, pg8::xshfl<16>(mx)); mx = fmaxf(mx, pg8::xshfl32(mx, lane));
    float lsum = 0.f; bf16x8 pf[NCH];
#pragma unroll
    for (int ch = 0; ch < NCH; ++ch) { float p[8];
#pragma unroll
        for (int t = 0; t < 2; ++t)
#pragma unroll
            for (int e = 0; e < 4; ++e) { p[4 * t + e] = __builtin_amdgcn_exp2f(s[ch][t][e] - mx); lsum += p[4 * t + e]; }
        v4u w; w.x = pk2(p[0], p[1]); w.y = pk2(p[2], p[3]); w.z = pk2(p[4], p[5]); w.w = pk2(p[6], p[7]);
        pf[ch] = __builtin_bit_cast(bf16x8, w); }
    lsum += pg8::xshfl<16>(lsum); lsum += pg8::xshfl32(lsum, lane);
    const float inv = 1.0f / lsum;
    f32x4 o[4];
    const LAS unsigned char* vl = lds + ATT_CV + li * ATT_CVP + gq * 16;
    if constexpr (!CTXQ) {
#define ATT_PV_CTX(half) do { _Pragma("unroll") for (int d2 = 0; d2 < 2; ++d2) { const int db = 2 * (half) + d2; f32x4 oo = (f32x4){0.f, 0.f, 0.f, 0.f}; \
        _Pragma("unroll") for (int cc = 0; cc < 8; ++cc) { const bf16x8 vf = *(const LAS bf16x8*)(vl + db * 16 * ATT_CVP + cc * 64); oo = __builtin_amdgcn_mfma_f32_16x16x32_bf16(vf, pf[8 + cc], oo, 0, 0, 0); } \
        o[db] = oo; } __builtin_amdgcn_sched_barrier(0); } while (0)
#define ATT_PV_NB(db) do { _Pragma("unroll") for (int ch = 0; ch < 8; ++ch) o[db] = __builtin_amdgcn_mfma_f32_16x16x32_bf16(vb[db][ch], pf[ch], o[db], 0, 0, 0); __builtin_amdgcn_sched_barrier(0); } while (0)
        ATT_LOADV(1); ATT_LOADV(2); ATT_LOADV(3); ATT_PV_CTX(0); ATT_PV_CTX(1); ATT_PV_NB(0); ATT_PV_NB(1); ATT_PV_NB(2); ATT_PV_NB(3);
#undef ATT_PV_CTX
#undef ATT_PV_NB
    } else {
#pragma unroll
        for (int db = 0; db < 4; ++db) { f32x4 oo = (f32x4){0.f, 0.f, 0.f, 0.f};
#pragma unroll
            for (int cc = 0; cc < 8; ++cc) { const bf16x8 vf = *(const LAS bf16x8*)(vl + db * 16 * ATT_CVP + cc * 64); oo = __builtin_amdgcn_mfma_f32_16x16x32_bf16(vf, pf[cc], oo, 0, 0, 0); }
            o[db] = oo; }
    }
#undef ATT_LOADV
#pragma unroll
    for (int db = 0; db < 4; ++db) { v2u w; w.x = pk2(o[db][0] * inv, o[db][1] * inv); w.y = pk2(o[db][2] * inv, o[db][3] * inv);
        *(v2u*)(O + (size_t)(qtok0 + li) * 1024 + h * 64 + 16 * db + 4 * gq) = w; }
}

__device__ __forceinline__ void attn_phase(unsigned char* ws, LAS unsigned char* lds, int j, bool ctxq, int tid, int lane, int wave, int vcu, int G) {
    const bf16* QK = (const bf16*)(ws + WS_QK); const bf16* VT = (const bf16*)(ws + WS_VT); bf16* O = (bf16*)(ws + WS_O);
    int Gl = G; asm volatile("" : "+s"(Gl));
    const int per = __builtin_amdgcn_readfirstlane((2048 + Gl - 1) / Gl);
    int cur_bh = -1, have_hi = 0, pf0 = 0, pfn = 0;
    v4u pt0 = (v4u){0u, 0u, 0u, 0u}, pt1 = pt0;
    const int fkey = tid >> 3, fc = tid & 7;
    const int fdst = ATT_KR + fkey * 128 + ((fc ^ att_kswz(fkey)) * 16);
    const int li = lane & 15, gq = lane >> 4;
    const int uend = min((vcu + 1) * per, 2048);
    for (int u = vcu * per; u < uend; ++u) {
        const int bh = u >> 5, rp = u & 31, b = bh >> 4, h = bh & 15;
        const int r = 2 * rp + (wave >> 2), jg = wave & 3, qtok0 = b * SEQ + r * 64 + 16 * jg;
        bf16x8 qf[2];
        { const bf16* qp = QK + (size_t)(qtok0 + li) * 2048 + h * 64 + 8 * gq; qf[0] = *(const bf16x8*)qp; qf[1] = *(const bf16x8*)(qp + 32); }
        __syncthreads();
        if (bh != cur_bh) {
            cur_bh = bh; have_hi = 0; pfn = 0;
            if (tid < 465) ((LAS float*)(lds + ATT_RPB))[32 + tid] = ((const float*)(ws + WS_PRM))[PRM_RPB + (j * 16 + h) * 465 + tid];
            const int cxbase = ML + b * CTXL;
            v4u tk[4], tv[4];
#pragma unroll
            for (int i = 0; i < 4; ++i) { const int c = tid + 512 * i;
                tk[i] = *(const v4u*)(QK + (size_t)(cxbase + (c >> 3)) * 2048 + 1024 + h * 64 + (c & 7) * 8);
                tv[i] = *(const v4u*)(VT + (size_t)(h * 64 + (c >> 5)) * MA + cxbase + (c & 31) * 8); }
#pragma unroll
            for (int i = 0; i < 4; ++i) { const int c = tid + 512 * i;
                *(LAS v4u*)(lds + ATT_CK + (c >> 3) * ATT_CKP + (c & 7) * 16) = tk[i];
                *(LAS v4u*)(lds + ATT_CV + (c >> 5) * ATT_CVP + (c & 31) * 16) = tv[i]; }
        }
        const bf16* ksrc = QK + (size_t)(b * SEQ + fkey) * 2048 + 1024 + h * 64 + fc * 8;
        if (pfn > 0) { *(LAS v4u*)(lds + fdst + (pf0 % ATT_NSLOT) * ATT_KRS) = pt0; if (pfn > 1) *(LAS v4u*)(lds + fdst + ((pf0 + 1) % ATT_NSLOT) * ATT_KRS) = pt1; have_hi = pf0 + pfn; }
        const int r0 = 2 * rp, nlo = min(max(r0 - 4, 0), 56), nhi = min(max(r0 + 1 - 4, 0), 56) + 8;
        const int f0 = max(nlo, have_hi);
        if (f0 < nhi) {
            v4u t[9];
#pragma unroll
            for (int i = 0; i < 9; ++i) t[i] = *(const v4u*)(ksrc + (size_t)min(f0 + i, nhi - 1) * 64 * 2048);
#pragma unroll
            for (int i = 0; i < 9; ++i) if (f0 + i < nhi) *(LAS v4u*)(lds + fdst + ((f0 + i) % ATT_NSLOT) * ATT_KRS) = t[i];
        }
        have_hi = nhi;
        __syncthreads();
        pfn = 0;
        if (false && u + 1 < uend && ((u + 1) >> 5) == bh) {
            const int q0 = 2 * (rp + 1), nhi2 = min(max(q0 + 1 - 4, 0), 56) + 8;
            pf0 = nhi; pfn = nhi2 - nhi;
            if (pfn > 0) pt0 = *(const v4u*)(ksrc + (size_t)pf0 * 64 * 2048);
            if (pfn > 1) pt1 = *(const v4u*)(ksrc + (size_t)(pf0 + 1) * 64 * 2048);
        }
        attn_wave<false>(qf, VT, O, lds, b, h, r, jg, qtok0, lane);
        if (ctxq && (rp & 15) == 0) { const int ctok0 = ML + b * CTXL + 128 * (rp >> 4) + 16 * wave;
            bf16x8 qc[2]; { const bf16* qp = QK + (size_t)(ctok0 + li) * 2048 + h * 64 + 8 * gq; qc[0] = *(const bf16x8*)qp; qc[1] = *(const bf16x8*)(qp + 32); }
            attn_wave<true>(qc, VT, O, lds, b, h, 0, 0, ctok0, lane); }
    }
}

#define LANEID() ({ unsigned z_ = 0u; asm volatile("" : "+s"(z_)); (int)__builtin_amdgcn_mbcnt_hi(~0u, __builtin_amdgcn_mbcnt_lo(~0u, z_)); })
#define XB_TMO      128
#define XB_XCNT(j)  (256  + 64 * (j))
#define XB_XSUB(j)  (1280 + 64 * (j))
#define XB_XGEN(j)  (2304 + 64 * (j))
#define XB_TOP      3328
#define XB_TOPGEN   3392
#define XCD_BAR_WORDS 3456
#define XB_SPIN_CAP (1u << 18)

__device__ __forceinline__ unsigned xb_ld(unsigned* p)              { return __hip_atomic_load(p, __ATOMIC_RELAXED, __HIP_MEMORY_SCOPE_AGENT); }
__device__ __forceinline__ unsigned xb_add(unsigned* p, unsigned v) { return __hip_atomic_fetch_add(p, v, __ATOMIC_RELAXED, __HIP_MEMORY_SCOPE_AGENT); }
__device__ __forceinline__ unsigned xb_xcc_id() { return (unsigned)__builtin_amdgcn_s_getreg((3 << 11) | 20) & 0xFu; }
#define XB_SPIN(cond, bar) do { unsigned _sp = 0; while (cond) { __builtin_amdgcn_s_sleep(1); \
    if ((++_sp & 255u) == 0u) { if (xb_ld(&(bar)[XB_TMO])) break; if (_sp > XB_SPIN_CAP) { atomicAdd(&(bar)[XB_TMO], 1u); break; } } } } while (0)

struct XcdBarrier {
    unsigned* bar; unsigned x; int w0;
    volatile LAS unsigned* st;
};

__device__ __forceinline__ XcdBarrier xcd_barrier_post(unsigned* bar, volatile LAS unsigned* st) {
    XcdBarrier b; b.bar = bar; b.x = xb_xcc_id(); b.st = st;
    if (threadIdx.x == 0) (void)xb_add(&bar[XB_XCNT(b.x)], 1u);
    return b;
}
__device__ __forceinline__ void xcd_barrier_complete(unsigned* bar, unsigned x, unsigned& nloc, unsigned& nx) {
    const unsigned G = gridDim.x * gridDim.y * gridDim.z;
    unsigned sum, cnt, mine, sp = 0u;
    for (;;) {
        sum = 0u; cnt = 0u; mine = 0u;
#pragma unroll
        for (unsigned j = 0; j < 16; ++j) { const unsigned c = xb_ld(&bar[XB_XCNT(j)]); sum += c; cnt += (c > 0u) ? 1u : 0u; }
        mine = xb_ld(&bar[XB_XCNT(x)]);
        if (sum == G) break;
        __builtin_amdgcn_s_sleep(1);
        if ((++sp & 255u) == 0u) { if (xb_ld(&bar[XB_TMO])) break; if (sp > XB_SPIN_CAP) { atomicAdd(&bar[XB_TMO], 1u); break; } }
    }
    nloc = mine > 0u ? mine : 1u; nx = cnt > 0u ? cnt : 1u;
}

__device__ __forceinline__ void xcd_barrier(const XcdBarrier& b) {
    asm volatile("s_waitcnt vmcnt(0)" ::: "memory");
    __syncthreads();
    if (b.w0 == 0 && LANEID() == 0) {
        unsigned* bar = b.bar;
        __builtin_amdgcn_s_waitcnt(0);
        unsigned nloc = b.st[0], nx = b.st[1];
        if (nloc == 0u) { xcd_barrier_complete(bar, b.x, nloc, nx); b.st[0] = nloc; b.st[1] = nx; }
        const unsigned old = xb_add(&bar[XB_XSUB(b.x)], 1u);
        const unsigned gen = old / nloc;
        if (old + 1u == (gen + 1u) * nloc) {
            __builtin_amdgcn_fence(__ATOMIC_RELEASE, "agent");
            asm volatile("s_waitcnt vmcnt(0)" ::: "memory");
            const unsigned og = xb_add(&bar[XB_TOP], 1u);
            const unsigned tg = og / nx;
            if (og + 1u == (tg + 1u) * nx) xb_add(&bar[XB_TOPGEN], 1u);
            else XB_SPIN(xb_ld(&bar[XB_TOPGEN]) == tg, bar);
            __builtin_amdgcn_fence(__ATOMIC_ACQUIRE, "agent");
            xb_add(&bar[XB_XGEN(b.x)], 1u);
            asm volatile("s_waitcnt vmcnt(0)" ::: "memory");
        } else {
            XB_SPIN(xb_ld(&bar[XB_XGEN(b.x)]) == gen, bar);
            __builtin_amdgcn_fence(__ATOMIC_ACQUIRE, "agent");
            asm volatile("s_waitcnt vmcnt(0)" ::: "memory");
        }
    }
    __syncthreads();
}

constexpr size_t WS_BAR = 0;
__global__ void __launch_bounds__(NT, 2) mega(Args a) {
    extern __shared__ __attribute__((aligned(16))) unsigned char lds_raw[];
    LAS unsigned char* lds = (LAS unsigned char*)lds_raw;
    cg::grid_group grid = cg::this_grid();
#ifndef PROBE_SYNC
#define PROBE_SYNC 0
#endif
#ifndef PROBE_ATTN
#define PROBE_ATTN 0
#endif
#ifndef PROBE_MIX
#define PROBE_MIX 0
#endif
#ifndef PROBE_ROW
#define PROBE_ROW 0
#endif
#ifndef PROBE_PRO
#define PROBE_PRO 0
#endif
    volatile LAS unsigned* bst = (volatile LAS unsigned*)(lds + LDS_BYTES - 16);
    if (threadIdx.x < 2) bst[threadIdx.x] = 0u;
    if (blockIdx.x == 0) for (int t = threadIdx.x; t < XCD_BAR_WORDS; t += NT) __hip_atomic_store((unsigned*)(a.ws + WS_BAR) + t, 0u, __ATOMIC_RELAXED, __HIP_MEMORY_SCOPE_AGENT);
    XcdBarrier xbar;
#define GSYNC() do { xcd_barrier(xbar); if (PROBE_SYNC) xcd_barrier(xbar); } while (0)
    const int G = gridDim.x, bid = blockIdx.x;
    const int wave0 = __builtin_amdgcn_readfirstlane((int)threadIdx.x >> 6);
    const int vcu = (G % 8 == 0) ? (bid % 8) * (G / 8) + bid / 8 : bid;
    const int NGW = G * NWAVES;
#define WSL() unsigned char* wsp = ws; int Gp = G, bp = bid; asm volatile("" : "+s"(wsp), "+s"(Gp), "+s"(bp)); (void)Gp; (void)bp
#define TIDS() int tid = wave0 * 64 + LANEID(); asm volatile("" : "+v"(tid)); int vcul = vcu; asm volatile("" : "+s"(vcul)); const int lane = tid & 63, wave = __builtin_amdgcn_readfirstlane(tid >> 6), gw = vcul * NWAVES + wave; (void)lane; (void)gw
    unsigned char* ws = a.ws; float* out = a.out;
    bf16* HN = (bf16*)(ws + WS_HN);
    const float* MOD = (const float*)(ws + WS_MOD);

    { TIDS(); prologue(a, lds, tid, lane, wave, bid, G, gw, NGW); if (PROBE_PRO) { __syncthreads(); prologue(a, lds, tid, lane, wave, bid, G, gw, NGW); } }
    grid.sync();
    xbar = xcd_barrier_post((unsigned*)(a.ws + WS_BAR), bst); xbar.w0 = wave0;
#pragma unroll 1
    for (int i = 0; i < 4; ++i) {
        const bool odd = (i & 1) != 0, last = (i == 3); const int j = i >> 1; const int Mact = last ? ML : MA;
        { TIDS(); WSL(); rowpass(wsp, i, 0, MA, i > 0 ? 11 : 0, (const float*)(wsp + WS_MOD) + (size_t)((i > 0 ? i - 1 : 0) * 5 + 4) * 6144 + 5 * 1024, lane, gw, NGW); if (PROBE_ROW) rowpass(wsp, i, 0, MA, i > 0 ? 11 : 0, (const float*)(wsp + WS_MOD) + (size_t)((i > 0 ? i - 1 : 0) * 5 + 4) * 6144 + 5 * 1024, lane, gw, NGW); }
        GSYNC();
        if (odd) {
            { WSL(); pg8::Gemm g{(const bf16*)(wsp + WS_HN), (const bf16*)(wsp + WS_WQKV) + (size_t)j * 3072 * 1024, MA, 2048, 1024}; pg8::StaticOrder S; S.init(MA, 2048, 1024, Gp, bp);
              pg8::EpiStoreBf16 E{(bf16*)(wsp + WS_QK), 2048, 0, 4, 0.125f * LOG2E};
              pg8::gemm_phase<pg8::EpiStoreBf16, pg8::StaticOrder, true, true>(lds, g, S, E, wave0 * 64 + LANEID()); }
            { WSL(); pg8::Gemm g{(const bf16*)(wsp + WS_WQKV) + (size_t)j * 3072 * 1024 + (size_t)2048 * 1024, (const bf16*)(wsp + WS_HN), 1024, MA, 1024}; pg8::StaticOrder S; S.init(1024, MA, 1024, Gp, (bp + Gp - (544 % Gp)) % Gp);
              pg8::EpiStoreBf16 E{(bf16*)(wsp + WS_VT), MA, 0, 0, 1.f};
              pg8::gemm_phase<pg8::EpiStoreBf16, pg8::StaticOrder, true, true>(lds, g, S, E, wave0 * 64 + LANEID()); }
        } else {
            { WSL(); pg8::Gemm g{(const bf16*)(wsp + WS_HN), (const bf16*)(wsp + WS_WIN) + (size_t)j * 1536 * 1024, MA, 1024, 1024}; pg8::StaticOrder S; S.init(MA, 1024, 1024, Gp, bp);
              pg8::EpiStoreBf16 E{(bf16*)(wsp + WS_UQ), 1024, 2, 0, 1.f};
              pg8::gemm_phase<pg8::EpiStoreBf16, pg8::StaticOrder, true, true>(lds, g, S, E, wave0 * 64 + LANEID()); }
            { WSL(); pg8::Gemm g{(const bf16*)(wsp + WS_WIN) + (size_t)j * 1536 * 1024 + (size_t)1024 * 1024, (const bf16*)(wsp + WS_HN), 512, MA, 1024}; pg8::StaticOrder S; S.init(512, MA, 1024, Gp, (bp + Gp - (272 % Gp)) % Gp);
              pg8::EpiGVt E{(bf16*)(wsp + WS_GVT), MA, (float*)(wsp + WS_STATS)};
              pg8::gemm_phase<pg8::EpiGVt, pg8::StaticOrder, true, true>(lds, g, S, E, wave0 * 64 + LANEID()); }
        }
        GSYNC();
        if (odd) { TIDS(); WSL(); int nrep = PROBE_ATTN ? 2 : 1; asm volatile("" : "+s"(nrep));
#pragma unroll 1
            for (int rep = 0; rep < nrep; ++rep) { attn_phase(wsp, lds, j, !last, tid, lane, wave, vcul, G); __syncthreads(); } }
        else { TIDS(); WSL(); mix_phase(wsp, lds, j, tid, lane, wave, bid, G); if (PROBE_MIX) { __syncthreads(); mix_phase(wsp, lds, j, tid, lane, wave, bid, G); } }
        GSYNC();
        { WSL(); pg8::Gemm g{odd ? (const bf16*)(wsp + WS_O) : (const bf16*)(wsp + WS_Y), odd ? (const bf16*)(wsp + WS_WONA) + (size_t)j * 1024 * 1024 : (const bf16*)(wsp + WS_WOAB) + (size_t)j * 1024 * 1024, Mact, 1024, 1024};
          pg8::SplitOrder S; S.init(Mact, 1024, 8, Gp, bp);
          pg8::EpiResGate E{(float*)(wsp + WS_XW), (const float*)(wsp + WS_MOD) + (size_t)i * 5 * 6144 + 2 * 1024, (float*)(wsp + WS_PART)};
          pg8::gemm_phase<pg8::EpiResGate, pg8::SplitOrder, true, true>(lds, g, S, E, wave0 * 64 + LANEID()); }
        GSYNC();
        { TIDS(); WSL(); rowpass(wsp, i, 1, Mact, last ? 0 : 8, (const float*)(wsp + WS_MOD) + (size_t)(i * 5 + 4) * 6144 + 2 * 1024, lane, gw, NGW); if (PROBE_ROW) rowpass(wsp, i, 1, Mact, last ? 0 : 8, (const float*)(wsp + WS_MOD) + (size_t)(i * 5 + 4) * 6144 + 2 * 1024, lane, gw, NGW); }
        GSYNC();
        { WSL(); pg8::Gemm g{(const bf16*)(wsp + WS_HN), (const bf16*)(wsp + WS_WFI) + (size_t)i * NFI * 1024, Mact, NFI, 1024}; pg8::StaticOrder S; S.init(Mact, NFI, 1024, Gp, bp);
          pg8::EpiSwiGLU E{(bf16*)(wsp + WS_H2), DFF};
          pg8::gemm_phase<pg8::EpiSwiGLU, pg8::StaticOrder, true, true>(lds, g, S, E, wave0 * 64 + LANEID());
#ifdef PROBE_FFI
          __syncthreads(); pg8::gemm_phase<pg8::EpiSwiGLU, pg8::StaticOrder, true, true>(lds, g, S, E, wave0 * 64 + LANEID());
#endif
        }
        GSYNC();
        { WSL(); pg8::Gemm g{(const bf16*)(wsp + WS_H2), (const bf16*)(wsp + WS_WFO) + (size_t)i * 1024 * DFF, Mact, 1024, DFF}; pg8::SplitOrder S; S.init(Mact, DFF, 11, Gp, bp);
          pg8::EpiResGate E{(float*)(wsp + WS_XW), (const float*)(wsp + WS_MOD) + (size_t)i * 5 * 6144 + 5 * 1024, (float*)(wsp + WS_PART)};
          pg8::gemm_phase<pg8::EpiResGate, pg8::SplitOrder, true, true>(lds, g, S, E, wave0 * 64 + LANEID()); }
        GSYNC();
    }
    { TIDS(); final_norm(ws, out, lane, gw, NGW); }
}

extern "C" void kernel_launch(void* const* d_in, const int* in_sizes, int n_in, void* d_out, int out_size, void* d_ws, size_t ws_size, hipStream_t stream) {
    static int grid = 0;
    if (grid == 0) {
        if (n_in != 21 || ws_size < WS_END) { fprintf(stderr, "kernel_launch: expected 21 inputs and >= %zu bytes of workspace (got %d, %zu)\n", (size_t)WS_END, n_in, ws_size); grid = -1; return; }
        int dev = 0, cus = 0, per_cu = 0;
        (void)hipGetDevice(&dev); (void)hipDeviceGetAttribute(&cus, hipDeviceAttributeMultiprocessorCount, dev);
        if (hipFuncSetAttribute((const void*)mega, hipFuncAttributeMaxDynamicSharedMemorySize, LDS_BYTES) != hipSuccess) fprintf(stderr, "kernel_launch: hipFuncSetAttribute failed\n");
        if (hipOccupancyMaxActiveBlocksPerMultiprocessor(&per_cu, (const void*)mega, NT, LDS_BYTES) != hipSuccess || per_cu < 1) { fprintf(stderr, "kernel_launch: occupancy query says %d\n", per_cu); per_cu = 1; }
        (void)hipGetLastError();
        grid = cus > 0 ? cus : 256;
    }
    if (grid < 0) return;
    Args a{};
    for (int i = 0; i < 21; ++i) a.in[i] = (const float*)d_in[i];
    a.out = (float*)d_out; a.ws = (unsigned char*)d_ws;
    void* args[] = {&a};
    hipError_t e = hipLaunchCooperativeKernel((const void*)mega, dim3(grid), dim3(NT), args, LDS_BYTES, stream);
    if (e != hipSuccess) fprintf(stderr, "kernel_launch: cooperative launch failed: %s (grid %d)\n", hipGetErrorString(e), grid);
}
```
